# Optimizing an MI355X kernel written in HIP

```python
import jax, jax.numpy as jnp
from jax import lax
import numpy as np

D_MODEL = 1024
BATCH = 16
SEQ = 256
DEPTH = 2
DEC_BATCH = 8
DEC_SEQ = 4096
PAST_LEN = 512

GRID_W = 64
MIXER_ORDER = ('rglru', 'pool')
N_MIXERS = len(MIXER_ORDER)
D_RNN = D_MODEL
N_LRU_BLOCKS = 4
LRU_BLOCK = D_RNN // N_LRU_BLOCKS
CONV_W = 4
CONV_LEFT = 2
LRU_C = 8.0
POOL_WINDOWS = (2, 4, 8, 16)
N_POOL_GROUPS = len(POOL_WINDOWS)
POOL_GROUP = D_MODEL // N_POOL_GROUPS
D_FF = -(-8 * D_MODEL // (3 * 256)) * 256
N_MOD = 6
EPS = 1e-6
POS_THETA = 10000.0

kernel_name = 'hybrid_rglru_pool_diffusion_step'


def rms_norm(x, g):
    x32 = x.astype(jnp.float32)
    y = x32 * lax.rsqrt(jnp.mean(x32 * x32, axis=-1, keepdims=True) + EPS)
    return (y * g.astype(jnp.float32)).astype(x.dtype)


def modulation(cond, w, b):
    m = jax.nn.silu(cond) @ w + b
    return jnp.split(m[:, None, :], N_MOD, axis=-1)


def grid_pos_emb(t_len, dtype):
    rows = t_len // GRID_W
    r = jnp.repeat(jnp.arange(rows), GRID_W)
    col = jnp.tile(jnp.arange(GRID_W), rows)
    quarter = D_MODEL // 4
    omega = 1.0 / (POS_THETA ** (jnp.arange(quarter, dtype=jnp.float32) / quarter))

    def emb(p):
        ang = p.astype(jnp.float32)[:, None] * omega[None, :]
        return jnp.concatenate([jnp.sin(ang), jnp.cos(ang)], axis=-1)

    return jnp.concatenate([emb(r), emb(col)], axis=-1).astype(dtype)


def centred_depthwise_conv(u, w, b):
    t_len = u.shape[1]
    up = jnp.pad(u, ((0, 0), (CONV_LEFT, CONV_W - 1 - CONV_LEFT), (0, 0)))
    y = up[:, 0:t_len] * w[0]
    for k in range(1, CONV_W):
        y = y + up[:, k:k + t_len] * w[k]
    return y + b


def _lin_combine(left, right):
    a1, b1 = left
    a2, b2 = right
    return a1 * a2, a2 * b1 + b2


def rglru_direction(u, wa, ba, wx, bx, lam, h0, reverse):
    bsz, t_len, _ = u.shape
    u32 = u.astype(jnp.float32)
    ub = u32.reshape(bsz, t_len, N_LRU_BLOCKS, LRU_BLOCK)
    ra = jnp.einsum('btnd,nde->btne', ub, wa.astype(jnp.float32)).reshape(bsz, t_len, D_RNN)
    ix = jnp.einsum('btnd,nde->btne', ub, wx.astype(jnp.float32)).reshape(bsz, t_len, D_RNN)
    r = jax.nn.sigmoid(ra + ba.astype(jnp.float32))
    i = jax.nn.sigmoid(ix + bx.astype(jnp.float32))
    log_a = -LRU_C * r * jax.nn.softplus(-lam.astype(jnp.float32))
    a = jnp.exp(log_a)
    b = jnp.sqrt(-jnp.expm1(2.0 * log_a)) * (i * u32)
    a_cum, b_cum = lax.associative_scan(_lin_combine, (a, b), reverse=reverse, axis=1)
    h = a_cum * h0.astype(jnp.float32)[:, None, :] + b_cum
    h_last = h[:, 0] if reverse else h[:, -1]
    return h, h_last


def rglru_mixer(h, h0, w_in, conv_w, conv_b, wa, ba, wx, bx, lam, w_out):
    z = h @ w_in
    gate_br, rec = jnp.split(z, 2, axis=-1)
    u = centred_depthwise_conv(rec, conv_w, conv_b)
    hf, sf = rglru_direction(u, wa[0], ba[0], wx[0], bx[0], lam[0], h0[:, 0], False)
    hb, sb = rglru_direction(u, wa[1], ba[1], wx[1], bx[1], lam[1], h0[:, 1], True)
    mixed = (hf + hb) * jax.nn.gelu(gate_br.astype(jnp.float32))
    y = mixed.astype(h.dtype) @ w_out
    return y, jnp.stack([sf, sb], axis=1).astype(h.dtype)


def centred_window_mean(u32, win):
    t_len = u32.shape[1]
    cs = jnp.pad(jnp.cumsum(u32, axis=1), ((0, 0), (1, 0), (0, 0)))
    t = jnp.arange(t_len)
    lo = jnp.clip(t - win // 2, 0, t_len)
    hi = jnp.clip(t + win // 2, 0, t_len)
    cnt = (hi - lo).astype(jnp.float32)
    return (cs[:, hi] - cs[:, lo]) / cnt[None, :, None]


def pool_mixer(h, pool_w, pool_b, pool_scale):
    bsz, t_len, _ = h.shape
    groups = h.astype(jnp.float32).reshape(bsz, t_len, N_POOL_GROUPS, POOL_GROUP)
    pooled = jnp.stack(
        [centred_window_mean(groups[:, :, gi], win) - groups[:, :, gi]
         for gi, win in enumerate(POOL_WINDOWS)], axis=2)
    y = jnp.einsum('btgc,gcd->btgd', pooled, pool_w.astype(jnp.float32)).reshape(bsz, t_len, D_MODEL)
    y = (y + pool_b.astype(jnp.float32)) * pool_scale.astype(jnp.float32)
    return y.astype(h.dtype)


def swiglu(h, w_in, w_out):
    gate, up = jnp.split(h @ w_in, 2, axis=-1)
    return (jax.nn.silu(gate) * up) @ w_out


def layer_forward(x, cond, p, h0):
    sh1, sc1, g1, sh2, sc2, g2 = modulation(cond, p['mod_w'], p['mod_b'])
    h = rms_norm(x, p['mix_pre_g']) * (1.0 + sc1) + sh1
    state = None
    if p['kind'] == 'rglru':
        y, state = rglru_mixer(h, h0, p['w_in'], p['conv_w'], p['conv_b'], p['gate_a_w'], p['gate_a_b'],
                               p['gate_x_w'], p['gate_x_b'], p['lam'], p['w_out'])
    else:
        y = pool_mixer(h, p['pool_w'], p['pool_b'], p['pool_scale'])
    x = x + g1 * rms_norm(y, p['mix_post_g'])
    h = rms_norm(x, p['ffn_pre_g']) * (1.0 + sc2) + sh2
    x = x + g2 * rms_norm(swiglu(h, p['ffn_w_in'], p['ffn_w_out']), p['ffn_post_g'])
    return x, state


def setup_inputs(seed: int = 0) -> dict:
    key = jax.random.key(seed)
    ks = iter(jax.random.split(key, 48))
    d = D_MODEL

    def nrm(shape, scale):
        return jax.random.normal(next(ks), shape, jnp.float32) * scale

    def gain(shape):
        return 1.0 + nrm(shape, 0.05)

    def lru_lambda():
        u = jax.random.uniform(next(ks), (2, D_RNN), jnp.float32, 0.9, 0.999)
        a0 = u ** (1.0 / LRU_C)
        return jnp.log(a0) - jnp.log1p(-a0)

    inp = {}
    inp['x_prompt'] = nrm((BATCH, SEQ, d), 1.0)
    inp['x_sample'] = nrm((DEC_BATCH, DEC_SEQ, d), 1.0)
    inp['state_l0_rglru'] = nrm((DEC_BATCH, 2, D_RNN), 0.5)
    inp['c'] = nrm((DEC_BATCH, d), 1.0)
    inp['c_ctx'] = nrm((d,), 1.0)
    inp['l0_mod_w'] = nrm((d, N_MOD * d), 0.5 * d ** -0.5)
    inp['l0_mod_b'] = nrm((N_MOD * d,), 0.01)
    inp['l0_mix_pre_g'] = gain((d,))
    inp['l0_mix_post_g'] = gain((d,))
    inp['l0_w_in'] = nrm((d, 2 * D_RNN), d ** -0.5)
    inp['l0_conv_w'] = nrm((CONV_W, D_RNN), CONV_W ** -0.5)
    inp['l0_conv_b'] = nrm((D_RNN,), 0.01)
    inp['l0_gate_a_w'] = nrm((2, N_LRU_BLOCKS, LRU_BLOCK, LRU_BLOCK), LRU_BLOCK ** -0.5)
    inp['l0_gate_a_b'] = nrm((2, D_RNN), 0.01)
    inp['l0_gate_x_w'] = nrm((2, N_LRU_BLOCKS, LRU_BLOCK, LRU_BLOCK), LRU_BLOCK ** -0.5)
    inp['l0_gate_x_b'] = nrm((2, D_RNN), 0.01)
    inp['l0_lambda'] = lru_lambda()
    inp['l0_w_out'] = nrm((D_RNN, d), D_RNN ** -0.5)
    inp['l0_ffn_pre_g'] = gain((d,))
    inp['l0_ffn_post_g'] = gain((d,))
    inp['l0_ffn_w_in'] = nrm((d, 2 * D_FF), d ** -0.5)
    inp['l0_ffn_w_out'] = nrm((D_FF, d), D_FF ** -0.5)
    inp['l1_mod_w'] = nrm((d, N_MOD * d), 0.5 * d ** -0.5)
    inp['l1_mod_b'] = nrm((N_MOD * d,), 0.01)
    inp['l1_mix_pre_g'] = gain((d,))
    inp['l1_mix_post_g'] = gain((d,))
    inp['l1_pool_w'] = nrm((N_POOL_GROUPS, POOL_GROUP, POOL_GROUP), POOL_GROUP ** -0.5)
    inp['l1_pool_b'] = nrm((d,), 0.01)
    inp['l1_pool_scale'] = gain((d,))
    inp['l1_ffn_pre_g'] = gain((d,))
    inp['l1_ffn_post_g'] = gain((d,))
    inp['l1_ffn_w_in'] = nrm((d, 2 * D_FF), d ** -0.5)
    inp['l1_ffn_w_out'] = nrm((D_FF, d), D_FF ** -0.5)
    return inp


def reference(x_prompt, x_sample, state_l0_rglru, c, c_ctx,
              l0_mod_w, l0_mod_b, l0_mix_pre_g, l0_mix_post_g, l0_w_in, l0_conv_w, l0_conv_b,
              l0_gate_a_w, l0_gate_a_b, l0_gate_x_w, l0_gate_x_b, l0_lambda, l0_w_out,
              l0_ffn_pre_g, l0_ffn_post_g, l0_ffn_w_in, l0_ffn_w_out,
              l1_mod_w, l1_mod_b, l1_mix_pre_g, l1_mix_post_g, l1_pool_w, l1_pool_b, l1_pool_scale,
              l1_ffn_pre_g, l1_ffn_post_g, l1_ffn_w_in, l1_ffn_w_out):
    layers = [
        dict(kind=MIXER_ORDER[0 % N_MIXERS], mod_w=l0_mod_w, mod_b=l0_mod_b,
             mix_pre_g=l0_mix_pre_g, mix_post_g=l0_mix_post_g, w_in=l0_w_in,
             conv_w=l0_conv_w, conv_b=l0_conv_b, gate_a_w=l0_gate_a_w, gate_a_b=l0_gate_a_b,
             gate_x_w=l0_gate_x_w, gate_x_b=l0_gate_x_b, lam=l0_lambda, w_out=l0_w_out,
             ffn_pre_g=l0_ffn_pre_g, ffn_post_g=l0_ffn_post_g,
             ffn_w_in=l0_ffn_w_in, ffn_w_out=l0_ffn_w_out),
        dict(kind=MIXER_ORDER[1 % N_MIXERS], mod_w=l1_mod_w, mod_b=l1_mod_b,
             mix_pre_g=l1_mix_pre_g, mix_post_g=l1_mix_post_g, pool_w=l1_pool_w,
             pool_b=l1_pool_b, pool_scale=l1_pool_scale,
             ffn_pre_g=l1_ffn_pre_g, ffn_post_g=l1_ffn_post_g,
             ffn_w_in=l1_ffn_w_in, ffn_w_out=l1_ffn_w_out),
    ]
    cached_states = {0: state_l0_rglru}

    y_prompt = x_prompt
    ctx_cond = c_ctx[None, :]
    new_states = {}
    for i in range(DEPTH):
        p = layers[i]
        h0 = jnp.zeros((y_prompt.shape[0], 2, D_RNN), y_prompt.dtype) if p['kind'] == 'rglru' else None
        y_prompt, st = layer_forward(y_prompt, ctx_cond, p, h0)
        if st is not None:
            new_states[i] = st

    y_sample = x_sample + grid_pos_emb(x_sample.shape[1], x_sample.dtype)[None]
    for i in range(DEPTH):
        p = layers[i]
        h0 = cached_states[i] if p['kind'] == 'rglru' else None
        y_sample, _ = layer_forward(y_sample, c, p, h0)

    return (y_prompt, y_sample, new_states[0])
```

```cpp
#include <hip/hip_runtime.h>
#include <hip/hip_cooperative_groups.h>
#include <cstdio>
namespace cg = cooperative_groups;

#ifndef PH_MASK
#define PH_MASK 0x7FFFF
#endif
#ifndef REP_MASK
#define REP_MASK 0x0
#endif
#ifndef MK_PER_PHASE
#define MK_PER_PHASE 0
#endif

#define LAS __attribute__((address_space(3)))
typedef unsigned short bf16_t;
typedef short bf16x8 __attribute__((ext_vector_type(8)));
typedef float f32x4 __attribute__((ext_vector_type(4)));
typedef float f32x2 __attribute__((ext_vector_type(2)));
typedef unsigned u32x4 __attribute__((ext_vector_type(4)));
typedef unsigned u32x2 __attribute__((ext_vector_type(2)));

constexpr int D = 1024, DFF = 2816, NCTX = 16 * 256, NLAT = 8 * 4096, TROWS = NCTX + NLAT;
constexpr int NCHUNK = TROWS / 128;
constexpr int LDS_BYTES = 135168 + 16;
constexpr int NPH = 19;

constexpr size_t al256(size_t x) { return (x + 255) & ~(size_t)255; }
constexpr size_t WS_BAR = 0;
constexpr size_t WS_BAR_BYTES = 3456 * 4;
constexpr size_t WS_MOD = al256(WS_BAR + WS_BAR_BYTES);
constexpr size_t WS_PE = al256(WS_MOD + 2 * 9 * 6144 * 4);
constexpr size_t WS_RSTD = al256(WS_PE + 64 * 512 * 4);
constexpr size_t WS_AGG = al256(WS_RSTD + (size_t)TROWS * 4);
constexpr size_t WS_CAR = al256(WS_AGG + (size_t)2 * 2 * NCHUNK * 1024 * 4);
constexpr size_t WS_WIN0 = al256(WS_CAR + (size_t)2 * NCHUNK * 1024 * 4);
constexpr size_t WS_WOUT0 = WS_WIN0 + (size_t)2048 * 1024 * 2;
constexpr size_t WS_FIN0 = WS_WOUT0 + (size_t)1024 * 1024 * 2;
constexpr size_t WS_FOUT0 = WS_FIN0 + (size_t)5632 * 1024 * 2;
constexpr size_t WS_FIN1 = WS_FOUT0 + (size_t)1024 * 2816 * 2;
constexpr size_t WS_FOUT1 = WS_FIN1 + (size_t)5632 * 1024 * 2;
constexpr size_t WS_POOLW = WS_FOUT1 + (size_t)1024 * 2816 * 2;
constexpr size_t WS_WG = WS_POOLW + (size_t)1024 * 256 * 2;
constexpr size_t MIB = 1024 * 1024;
constexpr size_t WS_BASE = al256(WS_WG + (size_t)16 * 256 * 256 * 2);
constexpr size_t WS_H = WS_BASE;
constexpr size_t WS_Y = WS_BASE + 72 * MIB;
constexpr size_t WS_Y1 = WS_BASE + 144 * MIB;
constexpr size_t WS_B = WS_BASE + 216 * MIB;
constexpr size_t WS_DBF = WS_BASE;
constexpr size_t WS_DBB = WS_BASE + 144 * MIB;
constexpr size_t WS_GACT = WS_BASE + 288 * MIB;
constexpr size_t WS_REC = WS_BASE + 360 * MIB;
constexpr size_t WS_END = WS_BASE + 432 * MIB;

struct Args { const float* in[33]; float* out; unsigned char* ws; int ph_lo, ph_hi; };

__device__ __forceinline__ unsigned cvt_pk_bf16(float lo, float hi) { unsigned r; asm volatile("v_cvt_pk_bf16_f32 %0, %1, %2" : "=v"(r) : "v"(lo), "v"(hi)); return r; }
__device__ __forceinline__ float bf_lo(unsigned w) { return __uint_as_float(w << 16); }
__device__ __forceinline__ float bf_hi(unsigned w) { return __uint_as_float(w & 0xffff0000u); }
__device__ __forceinline__ float sigmoid_f(float x) { return __builtin_amdgcn_rcpf(1.0f + __builtin_amdgcn_exp2f(-1.44269504089f * x)); }
__device__ __forceinline__ float silu_f(float x) { return x * sigmoid_f(x); }
__device__ __forceinline__ float gelu_tanh_f(float x) { const float z = x + 0.044715f * x * x * x; return x * __builtin_amdgcn_rcpf(1.0f + __builtin_amdgcn_exp2f(-2.0f * 0.7978845608f * 1.44269504089f * z)); }
__device__ __forceinline__ float xchg16(float x, bool oddrow) { const u32x2 r = __builtin_amdgcn_permlane16_swap(__float_as_uint(x), __float_as_uint(x), false, false); return __uint_as_float(oddrow ? r.x : r.y); }
__device__ __forceinline__ float xchg32(float x, bool upper) { const u32x2 r = __builtin_amdgcn_permlane32_swap(__float_as_uint(x), __float_as_uint(x), false, false); return __uint_as_float(upper ? r.x : r.y); }
__device__ __forceinline__ float wave_sum(float v) {
#pragma unroll
    for (int o = 32; o >= 1; o >>= 1) v += __shfl_xor(v, o);
    return v;
}

#define XB_TMO      128
#define XB_XCNT(j)  (256  + 64 * (j))
#define XB_XSUB(j)  (1280 + 64 * (j))
#define XB_XGEN(j)  (2304 + 64 * (j))
#define XB_TOP      3328
#define XB_TOPGEN   3392
#define XCD_BAR_WORDS 3456
#define XB_SPIN_CAP (1u << 22)
__device__ __forceinline__ unsigned xb_ld(unsigned* p)              { return __hip_atomic_load(p, __ATOMIC_RELAXED, __HIP_MEMORY_SCOPE_AGENT); }
__device__ __forceinline__ unsigned xb_add(unsigned* p, unsigned v) { return __hip_atomic_fetch_add(p, v, __ATOMIC_RELAXED, __HIP_MEMORY_SCOPE_AGENT); }
__device__ __forceinline__ unsigned xb_xcc_id() { return (unsigned)__builtin_amdgcn_s_getreg((3 << 11) | 20) & 0xFu; }
#define XB_SPIN(cond, bar) do { unsigned _sp = 0; while (cond) { __builtin_amdgcn_s_sleep(1); \
    if ((++_sp & 255u) == 0u) { if (xb_ld(&(bar)[XB_TMO])) break; if (_sp > XB_SPIN_CAP) { atomicAdd(&(bar)[XB_TMO], 1u); break; } } } } while (0)
struct XcdBarrier { unsigned* bar; unsigned x; volatile LAS unsigned* st; };
__device__ __forceinline__ XcdBarrier xcd_barrier_post(unsigned* bar, volatile LAS unsigned* st) {
    XcdBarrier b; b.bar = bar; b.x = xb_xcc_id(); b.st = st;
    if (threadIdx.x == 0) (void)xb_add(&bar[XB_XCNT(b.x)], 1u);
    return b;
}
__device__ __forceinline__ void xcd_barrier_complete(unsigned* bar, unsigned x, unsigned& nloc, unsigned& nx) {
    const unsigned G = gridDim.x * gridDim.y * gridDim.z;
    unsigned sum, cnt, mine, sp = 0u;
    for (;;) {
        sum = 0u; cnt = 0u; mine = 0u;
#pragma unroll
        for (unsigned j = 0; j < 16; ++j) { const unsigned c = xb_ld(&bar[XB_XCNT(j)]); sum += c; cnt += (c > 0u) ? 1u : 0u; mine = (j == x) ? c : mine; }
        if (sum == G) break;
        __builtin_amdgcn_s_sleep(1);
        if ((++sp & 255u) == 0u) { if (xb_ld(&bar[XB_TMO])) break; if (sp > XB_SPIN_CAP) { atomicAdd(&bar[XB_TMO], 1u); break; } }
    }
    nloc = mine > 0u ? mine : 1u; nx = cnt > 0u ? cnt : 1u;
}
__device__ __forceinline__ void xcd_barrier(const XcdBarrier& b) {
    asm volatile("s_waitcnt vmcnt(0)" ::: "memory");
    __syncthreads();
    if (threadIdx.x == 0) {
        unsigned* bar = b.bar;
        __builtin_amdgcn_s_waitcnt(0);
        unsigned nloc = b.st[0], nx = b.st[1];
        if (nloc == 0u) { xcd_barrier_complete(bar, b.x, nloc, nx); b.st[0] = nloc; b.st[1] = nx; }
        const unsigned old = xb_add(&bar[XB_XSUB(b.x)], 1u);
        const unsigned gen = old / nloc;
        if (old + 1u == (gen + 1u) * nloc) {
            __builtin_amdgcn_fence(__ATOMIC_RELEASE, "agent");
            asm volatile("s_waitcnt vmcnt(0)" ::: "memory");
            const unsigned og = xb_add(&bar[XB_TOP], 1u);
            const unsigned tg = og / nx;
            if (og + 1u == (tg + 1u) * nx) xb_add(&bar[XB_TOPGEN], 1u);
            else XB_SPIN(xb_ld(&bar[XB_TOPGEN]) == tg, bar);
            __builtin_amdgcn_fence(__ATOMIC_ACQUIRE, "agent");
            xb_add(&bar[XB_XGEN(b.x)], 1u);
            asm volatile("s_waitcnt vmcnt(0)" ::: "memory");
        } else {
            XB_SPIN(xb_ld(&bar[XB_XGEN(b.x)]) == gen, bar);
            __builtin_amdgcn_fence(__ATOMIC_ACQUIRE, "agent");
            asm volatile("s_waitcnt vmcnt(0)" ::: "memory");
        }
    }
    __syncthreads();
}

namespace pg8 {
constexpr int BM = 256, BK = 64, HALF = 128, HTB = HALF * BK * 2, STAGE_BYTES = 8 * HTB, NXCD = 8, WGM = 8;
__host__ __device__ __forceinline__ int lds_byte(int r, int c) { const int st = (r >> 4) * 2 + (c >> 5), rr = r & 15, cc = c & 31, ob = rr * 64 + cc * 2; return st * 1024 + (ob ^ (((ob >> 9) & 1) << 5)); }
__host__ __device__ __forceinline__ void stage_rc(int b, int& R, int& C) { const int st = b / 1024, sb = b % 1024, swz = sb ^ (((sb >> 9) & 1) << 5); R = (st >> 1) * 16 + swz / 64; C = (st & 1) * 32 + (swz % 64) / 2; }
__host__ __device__ __forceinline__ int perm32(int rho) { const int n = rho >> 4, i = rho & 15; return 8 * (i >> 2) + 4 * n + (i & 3); }
struct Unit { int pm, pn, kt0, nkt; };
struct Gemm { const bf16_t* A; const bf16_t* Bt; int M, N, K, lda, diag; };
struct StaticOrder {
    int nM, nN, nwg, G, c, ntfull, tail;
    __device__ __forceinline__ void init(int M, int N, int K, int G_, int c_, int tail_) { nM = M / BM; nN = N / BM; G = G_; c = c_; ntfull = K / BK; tail = (tail_ && G_ == 256 && nM == 144 && nN == 4 && ntfull == 44) ? 1 : 0; if (tail) nM = 128; nwg = nM * nN; }
    __device__ __forceinline__ bool next(int i, Unit& u) const {
        if (tail && i == 2) { const int tile = c >> 2, ks = c & 3; u.pm = 128 + (tile >> 2); u.pn = tile & 3; u.kt0 = ks < 2 ? ks * 12 : 24 + (ks - 2) * 10; u.nkt = ks < 2 ? 12 : 10; return true; }
        const long L = (long)i * G + c; if (L >= nwg) return false;
        int wgid = (int)L; { const int q = nwg / NXCD, r = nwg % NXCD, xcd = wgid % NXCD, off = wgid / NXCD; wgid = (xcd < r ? xcd * (q + 1) : r * (q + 1) + (xcd - r) * q) + off; }
        const int nig = WGM * nN, gid = wgid / nig, fm = gid * WGM, gsz = (nM - fm) < WGM ? (nM - fm) : WGM;
        u.pm = fm + ((wgid % nig) % gsz); u.pn = (wgid % nig) / gsz; u.kt0 = 0; u.nkt = ntfull; return true;
    }
};
struct Epi {
    int mode;
    bf16_t* O0; bf16_t* O1; const float* pb; const float* ps; float* PART; int ntfull;
    __device__ __forceinline__ void operator()(const f32x4 (&acc)[2][2][4][2], const Unit& u, int wr, int wc, int fr, int fq) const {
        const int row0 = u.pm * BM + wr * 64 + fr;
        if (u.nkt != ntfull) {
            const int ks = u.kt0 == 0 ? 0 : (u.kt0 == 12 ? 1 : (u.kt0 == 24 ? 2 : 3)), tile = (u.pm - 128) * 4 + u.pn;
            float* dst = PART + (size_t)(ks * 64 + tile) * 65536 + (size_t)(wr * 64 + fr) * 256 + wc * 32 + 8 * fq;
#pragma unroll
            for (int ai = 0; ai < 2; ++ai)
#pragma unroll
                for (int m = 0; m < 4; ++m)
#pragma unroll
                    for (int bj = 0; bj < 2; ++bj)
#pragma unroll
                        for (int n = 0; n < 2; ++n) *(f32x4*)(dst + (size_t)(ai * HALF + m * 16) * 256 + bj * HALF + 4 * n) = acc[ai][bj][m][n];
            return;
        }
        if (mode == 2) {
            const int col0 = u.pn * 128 + wc * 32 + 8 * fq;
#pragma unroll
            for (int ai = 0; ai < 2; ++ai)
#pragma unroll
                for (int m = 0; m < 4; ++m) {
                    bf16_t* rowp = O0 + (size_t)(row0 + ai * HALF + m * 16) * DFF + col0;
                    const f32x4 g0 = acc[ai][0][m][0], g1 = acc[ai][0][m][1], u0 = acc[ai][1][m][0], u1 = acc[ai][1][m][1];
                    u32x4 w;
#define SWG(gv, uv) (((gv) * (uv)) * __builtin_amdgcn_rcpf(1.0f + __builtin_amdgcn_exp2f(gv)))
                    w.x = cvt_pk_bf16(SWG(g0[0], u0[0]), SWG(g0[1], u0[1])); w.y = cvt_pk_bf16(SWG(g0[2], u0[2]), SWG(g0[3], u0[3]));
                    w.z = cvt_pk_bf16(SWG(g1[0], u1[0]), SWG(g1[1], u1[1])); w.w = cvt_pk_bf16(SWG(g1[2], u1[2]), SWG(g1[3], u1[3]));
#undef SWG
                    __builtin_nontemporal_store(w, (u32x4*)rowp);
                }
        } else {
            bf16_t* base = O0; int colt = u.pn * BM; bool act = false;
            if (mode == 0) { if (u.pn >= 4) { base = O1; colt -= 1024; } else act = true; }
            const int col0 = colt + wc * 32 + 8 * fq;
            f32x4 bv[2][2], sv[2][2];
#pragma unroll
            for (int bj = 0; bj < 2; ++bj)
#pragma unroll
                for (int n = 0; n < 2; ++n) {
                    if (mode == 3) { bv[bj][n] = *(const f32x4*)(pb + col0 + bj * HALF + 4 * n); sv[bj][n] = *(const f32x4*)(ps + col0 + bj * HALF + 4 * n); }
                    else { bv[bj][n] = (f32x4){0.f, 0.f, 0.f, 0.f}; sv[bj][n] = (f32x4){1.f, 1.f, 1.f, 1.f}; }
                }
#pragma unroll
            for (int ai = 0; ai < 2; ++ai)
#pragma unroll
                for (int m = 0; m < 4; ++m) {
                    bf16_t* rowp = base + (size_t)(row0 + ai * HALF + m * 16) * D + col0;
#pragma unroll
                    for (int bj = 0; bj < 2; ++bj) {
                        f32x4 v0 = (acc[ai][bj][m][0] + bv[bj][0]) * sv[bj][0], v1 = (acc[ai][bj][m][1] + bv[bj][1]) * sv[bj][1];
                        if (act) {
#pragma unroll
                            for (int j = 0; j < 4; ++j) { v0[j] = gelu_tanh_f(v0[j]); v1[j] = gelu_tanh_f(v1[j]); }
                        }
                        u32x4 w; w.x = cvt_pk_bf16(v0[0], v0[1]); w.y = cvt_pk_bf16(v0[2], v0[3]); w.z = cvt_pk_bf16(v1[0], v1[1]); w.w = cvt_pk_bf16(v1[2], v1[3]);
                        *(u32x4*)(rowp + bj * HALF) = w;
                    }
                }
        }
    }
};

__device__ __forceinline__ void gemm_phase(LAS unsigned char* lds, const Gemm g, const StaticOrder& S, const Epi& E) {
    const int tid = threadIdx.x, wid = __builtin_amdgcn_readfirstlane(tid >> 6), lane = tid & 63, wr = wid >> 2, wc = wid & 3, fr = lane & 15, fq = lane >> 4;
    const int K = g.K, lda = g.lda;
    unsigned voffA[2], voffB[2];
#pragma unroll
    for (int i = 0; i < 2; ++i) { int R, C; stage_rc(tid * 16 + i * 8192, R, C); const int Rb = (R & ~31) + perm32(R & 31);
        voffA[i] = (unsigned)(R * lda + C) * 2u; voffB[i] = (unsigned)(Rb * K + C) * 2u; }
    const size_t kstep = (size_t)(BK * 2);
    const size_t hstepA = (size_t)HALF * lda * 2, hstepB = (size_t)HALF * K * 2;
    const size_t tstepA = 2 * hstepA, tstepB = 2 * hstepB;
    const size_t dstep = g.diag ? (size_t)K * 2 : 0;
    const unsigned ldsw = (unsigned)wid * 1024u;
    const int aoff = lds_byte(wr * 64 + fr, fq * 8), boff = lds_byte(wc * 32 + fr, fq * 8);
#define PG8_SA(b, h) (((b) * 2 + (h)) * HTB)
#define PG8_SB(b, h) ((4 + (b) * 2 + (h)) * HTB)
#define PG8_STAGE(bufoff, gbase, voff) do { _Pragma("unroll") for (int _i = 0; _i < 2; ++_i) \
        __builtin_amdgcn_global_load_lds((const unsigned*)((const char*)(gbase) + (voff)[_i]), (LAS unsigned*)(lds + (bufoff) + ldsw + _i * 8192), 16, 0, 0); } while (0)
#define PG8_LDA(dst, b, h) do { _Pragma("unroll") for (int m = 0; m < 4; ++m) _Pragma("unroll") for (int k = 0; k < 2; ++k) dst[m][k] = *(const LAS bf16x8*)(lds + PG8_SA(b, h) + aoff + m * 2048 + k * 1024); } while (0)
#define PG8_LDB(dst, b, h) do { _Pragma("unroll") for (int n = 0; n < 2; ++n) _Pragma("unroll") for (int k = 0; k < 2; ++k) dst[n][k] = *(const LAS bf16x8*)(lds + PG8_SB(b, h) + boff + n * 2048 + k * 1024); } while (0)
#define PG8_MMA(ai, bj, At, Bt) do { __builtin_amdgcn_s_setprio(1); _Pragma("unroll") for (int m = 0; m < 4; ++m) _Pragma("unroll") for (int n = 0; n < 2; ++n) _Pragma("unroll") for (int k = 0; k < 2; ++k) \
        acc[ai][bj][m][n] = __builtin_amdgcn_mfma_f32_16x16x32_bf16(Bt[n][k], At[m][k], acc[ai][bj][m][n], 0, 0, 0); __builtin_amdgcn_s_setprio(0); } while (0)
#define PG8_WAIT_V(n) asm volatile("s_waitcnt vmcnt(" #n ")" ::: "memory")
#define PG8_WAIT_L(n) asm volatile("s_waitcnt lgkmcnt(" #n ")" ::: "memory")
#define PG8_BAR __builtin_amdgcn_s_barrier()
#define PG8_SCHED __builtin_amdgcn_sched_barrier(0)
    Unit cur, nxt; int ui = 0;
    if (!S.next(0, cur)) return;
    f32x4 acc[2][2][4][2];
#pragma unroll
    for (int a = 0; a < 2; ++a)
#pragma unroll
        for (int b = 0; b < 2; ++b)
#pragma unroll
            for (int m = 0; m < 4; ++m)
#pragma unroll
                for (int n = 0; n < 2; ++n) acc[a][b][m][n] = (f32x4){0.f, 0.f, 0.f, 0.f};
    bf16x8 At[4][2], B0[2][2], B1[2][2];
    const char* cA = (const char*)g.A + (size_t)cur.pm * tstepA + (size_t)cur.pn * dstep + (size_t)cur.kt0 * kstep; const char* cB = (const char*)g.Bt + (size_t)cur.pn * tstepB + (size_t)cur.kt0 * kstep;
    PG8_STAGE(PG8_SB(0, 0), cB, voffB); PG8_STAGE(PG8_SB(0, 1), cB + hstepB, voffB); PG8_STAGE(PG8_SA(0, 0), cA, voffA); PG8_STAGE(PG8_SA(0, 1), cA + hstepA, voffA);
    if (wr == 1) PG8_BAR;
    PG8_WAIT_V(2); PG8_BAR;
    PG8_STAGE(PG8_SB(1, 0), cB + kstep, voffB); PG8_STAGE(PG8_SA(1, 0), cA + kstep, voffA); PG8_STAGE(PG8_SB(1, 1), cB + hstepB + kstep, voffB);
    PG8_WAIT_V(6); PG8_BAR;
    for (;;) {
        const bool has_next = S.next(ui + 1, nxt);
        const char* nA = has_next ? (const char*)g.A + (size_t)nxt.pm * tstepA + (size_t)nxt.pn * dstep + (size_t)nxt.kt0 * kstep : cA; const char* nB = has_next ? (const char*)g.Bt + (size_t)nxt.pn * tstepB + (size_t)nxt.kt0 * kstep : cB;
        const int nt = cur.nkt;
        for (int t = 0; t < nt; t += 2) {
            const bool last = (t == nt - 2);
            const char* a1 = cA + (size_t)(t + 1) * kstep;
            const char* a2 = last ? nA : cA + (size_t)(t + 2) * kstep; const char* b2 = last ? nB : cB + (size_t)(t + 2) * kstep;
            const char* a3 = a2 + kstep; const char* b3 = b2 + kstep;
            PG8_LDB(B0, 0, 0); PG8_LDB(B1, 0, 1); PG8_SCHED; PG8_LDA(At, 0, 0); PG8_STAGE(PG8_SA(1, 1), a1 + hstepA, voffA);
            PG8_WAIT_V(8); PG8_WAIT_L(0); PG8_BAR; PG8_MMA(0, 0, At, B0); PG8_MMA(0, 1, At, B1); PG8_BAR; PG8_SCHED;
            PG8_LDA(At, 0, 1); PG8_STAGE(PG8_SB(0, 0), b2, voffB); PG8_STAGE(PG8_SB(0, 1), b2 + hstepB, voffB); PG8_STAGE(PG8_SA(0, 0), a2, voffA);
            PG8_WAIT_V(8); PG8_WAIT_L(0); PG8_BAR; PG8_MMA(1, 0, At, B0); PG8_MMA(1, 1, At, B1); PG8_BAR; PG8_SCHED;
            PG8_LDB(B0, 1, 0); PG8_LDB(B1, 1, 1); PG8_SCHED; PG8_LDA(At, 1, 0); PG8_STAGE(PG8_SA(0, 1), a2 + hstepA, voffA);
            PG8_WAIT_V(8); PG8_WAIT_L(0); PG8_BAR; PG8_MMA(0, 0, At, B0); PG8_MMA(0, 1, At, B1); PG8_BAR; PG8_SCHED;
            PG8_LDA(At, 1, 1); PG8_STAGE(PG8_SB(1, 0), b3, voffB); PG8_STAGE(PG8_SB(1, 1), b3 + hstepB, voffB); PG8_STAGE(PG8_SA(1, 0), a3, voffA);
            PG8_WAIT_V(8); PG8_WAIT_L(0); PG8_BAR; PG8_MMA(1, 0, At, B0); PG8_MMA(1, 1, At, B1); PG8_BAR; PG8_SCHED;
        }
        if (wr == 0) PG8_BAR;
        E(acc, cur, wr, wc, fr, fq);
        if (!has_next) break;
#pragma unroll
        for (int a = 0; a < 2; ++a)
#pragma unroll
            for (int b = 0; b < 2; ++b)
#pragma unroll
                for (int m = 0; m < 4; ++m)
#pragma unroll
                    for (int n = 0; n < 2; ++n) acc[a][b][m][n] = (f32x4){0.f, 0.f, 0.f, 0.f};
        cur = nxt; cA = nA; cB = nB; ++ui;
        if (wr == 1) PG8_BAR;
    }
    PG8_WAIT_V(0);
    PG8_BAR;
#undef PG8_SA
#undef PG8_SB
#undef PG8_STAGE
#undef PG8_LDA
#undef PG8_LDB
#undef PG8_MMA
#undef PG8_WAIT_V
#undef PG8_WAIT_L
#undef PG8_BAR
#undef PG8_SCHED
}
}

__device__ __forceinline__ void tail_reduce(const float* PART, bf16_t* Y) {
    for (int id = blockIdx.x * 512 + threadIdx.x; id < 64 * 8192; id += gridDim.x * 512) {
        const int tile = id >> 13, rem = id & 8191, r = rem >> 5, c8 = (rem & 31) * 8;
        f32x4 s0 = (f32x4){0.f, 0.f, 0.f, 0.f}, s1 = s0;
#pragma unroll
        for (int ks = 0; ks < 4; ++ks) { const float* p = PART + (size_t)(ks * 64 + tile) * 65536 + (size_t)r * 256 + c8; s0 += *(const f32x4*)p; s1 += *(const f32x4*)(p + 4); }
        u32x4 w; w.x = cvt_pk_bf16(s0[0], s0[1]); w.y = cvt_pk_bf16(s0[2], s0[3]); w.z = cvt_pk_bf16(s1[0], s1[1]); w.w = cvt_pk_bf16(s1[2], s1[3]);
        *(u32x4*)(Y + (size_t)(32768 + (tile >> 2) * 256 + r) * 1024 + (tile & 3) * 256 + c8) = w;
    }
}

__device__ __forceinline__ void conv_tile(LAS float* tile, const float* src, int ldsrc, int k0, int c0, bf16_t* dst, int ldd, int n0, int kd0, float scale = 1.0f) {
    const int tid = threadIdx.x;
#pragma unroll
    for (int i = 0; i < 2; ++i) { const int e = tid + i * 512, r = e >> 4, c4 = e & 15;
        const f32x4 v = __builtin_nontemporal_load((const f32x4*)(src + (size_t)(k0 + r) * ldsrc + c0 + c4 * 4));
        tile[r * 65 + c4 * 4 + 0] = v[0]; tile[r * 65 + c4 * 4 + 1] = v[1]; tile[r * 65 + c4 * 4 + 2] = v[2]; tile[r * 65 + c4 * 4 + 3] = v[3]; }
    __syncthreads();
    { const int kg = tid & 7, n = tid >> 3; float f[8];
#pragma unroll
      for (int j = 0; j < 8; ++j) f[j] = tile[(kg * 8 + j) * 65 + n] * scale;
      u32x4 w; w.x = cvt_pk_bf16(f[0], f[1]); w.y = cvt_pk_bf16(f[2], f[3]); w.z = cvt_pk_bf16(f[4], f[5]); w.w = cvt_pk_bf16(f[6], f[7]);
      *(u32x4*)(dst + (size_t)(n0 + n) * ldd + kd0 + kg * 8) = w; }
    __syncthreads();
}

__device__ __forceinline__ void phase_prologue(const Args& a, LAS unsigned char* lds) {
    const int tid = threadIdx.x, bid = blockIdx.x, G = gridDim.x;
    unsigned char* ws = a.ws;
    {
        LAS float* s = (LAS float*)lds;
        LAS float* red = (LAS float*)(lds + 9 * 1024 * 4);
        for (int i = tid; i < 9 * 1024; i += 512) { const int r = i >> 10, k = i & 1023; const float v = (r == 0) ? a.in[4][k] : a.in[3][(r - 1) * 1024 + k]; s[i] = silu_f(v); }
        __syncthreads();
        for (int slab = bid; slab < 256; slab += G) {
            const int l = slab >> 7, n0 = (slab & 127) * 48;
            const float* W = a.in[l ? 22 : 5]; const float* bias = a.in[l ? 23 : 6];
            const int kk = tid / 12, n4 = tid % 12;
            float acc[9][4];
#pragma unroll
            for (int r = 0; r < 9; ++r)
#pragma unroll
                for (int j = 0; j < 4; ++j) acc[r][j] = 0.f;
            if (kk < 42) {
#pragma unroll 5
                for (int i = 0; i < 25; ++i) { const int k = kk + 42 * i;
                    if (k < 1024) { const f32x4 w = __builtin_nontemporal_load((const f32x4*)(W + (size_t)k * 6144 + n0 + n4 * 4));
#pragma unroll
                        for (int r = 0; r < 9; ++r) { const float sv = s[r * 1024 + k];
#pragma unroll
                            for (int j = 0; j < 4; ++j) acc[r][j] += sv * w[j]; } } }
#pragma unroll
                for (int r = 0; r < 9; ++r)
#pragma unroll
                    for (int j = 0; j < 4; ++j) red[(kk * 9 + r) * 48 + n4 * 4 + j] = acc[r][j];
            }
            __syncthreads();
            if (tid < 432) { const int r = tid / 48, n = tid % 48; float t = 0.f;
                for (int k2 = 0; k2 < 42; ++k2) t += red[(k2 * 9 + r) * 48 + n];
                ((float*)(ws + WS_MOD))[(size_t)(l * 9 + r) * 6144 + n0 + n] = t + bias[n0 + n]; }
            __syncthreads();
        }
    }
    for (int i = bid * 512 + tid; i < 64 * 512; i += G * 512) { const int p = i >> 9, j = i & 255; const float om = 1.0f / powf(10000.0f, (float)j * (1.0f / 256.0f)); const float ang = (float)p * om;
        ((float*)(ws + WS_PE))[i] = (i & 256) ? cosf(ang) : sinf(ang); }
    {
        LAS float* tile = (LAS float*)lds;
        constexpr int T0 = 512, T1 = T0 + 256, T2 = T1 + 1408, T3 = T2 + 704, T4 = T3 + 1408, T5 = T4 + 704, T6 = T5 + 64, T7 = T6 + 256;
        for (int t = bid; t < T7; t += G) {
            if (t < T0) { const int kt = t & 15, ntl = t >> 4; conv_tile(tile, a.in[9], 2048, kt * 64, ntl * 64, (bf16_t*)(ws + WS_WIN0), 1024, ntl * 64, kt * 64); }
            else if (t < T1) { const int u = t - T0, kt = u & 15, ntl = u >> 4; conv_tile(tile, a.in[17], 1024, kt * 64, ntl * 64, (bf16_t*)(ws + WS_WOUT0), 1024, ntl * 64, kt * 64); }
            else if (t < T2 || (t >= T3 && t < T4)) { const bool l1 = t >= T3; const int u = t - (l1 ? T3 : T1), kt = u & 15, ntl = u >> 4;
                const int n0 = ntl * 64, pn = n0 >> 8, bj = (n0 & 255) >> 7, j0 = n0 & 127, c0 = bj * DFF + pn * 128 + j0;
                conv_tile(tile, a.in[l1 ? 31 : 20], 2 * DFF, kt * 64, c0, (bf16_t*)(ws + (l1 ? WS_FIN1 : WS_FIN0)), 1024, n0, kt * 64, bj ? -0.69314718056f : -1.44269504089f); }
            else if (t < T3 || (t >= T4 && t < T5)) { const bool l1 = t >= T4; const int u = t - (l1 ? T4 : T2), kt = u % 44, ntl = u / 44;
                conv_tile(tile, a.in[l1 ? 32 : 21], 1024, kt * 64, ntl * 64, (bf16_t*)(ws + (l1 ? WS_FOUT1 : WS_FOUT0)), DFF, ntl * 64, kt * 64); }
            else if (t < T6) { const int u = t - T5, g = u >> 4, kt = u & 3, ntl = (u >> 2) & 3;
                conv_tile(tile, a.in[26] + (size_t)g * 65536, 256, kt * 64, ntl * 64, (bf16_t*)(ws + WS_POOLW), 256, g * 256 + ntl * 64, kt * 64); }
            else { const int u = t - T6, mtx = u >> 4, kt = u & 3, ntl = (u >> 2) & 3;
                const int dir = mtx >> 3, gate = (mtx >> 2) & 1, blk = mtx & 3;
                conv_tile(tile, a.in[gate ? 14 : 12] + (size_t)(dir * 4 + blk) * 65536, 256, kt * 64, ntl * 64, (bf16_t*)(ws + WS_WG) + (size_t)mtx * 65536, 256, ntl * 64, kt * 64, -1.44269504089f); }
        }
    }
}

template <int MODE>
__device__ __forceinline__ void rows_load(const float* xsrc, const bf16_t* Y, const float* PE, int row, int lane, f32x4 (&x)[4], u32x2 (&yw)[4], f32x4 (&pe)[4]) {
#pragma unroll
    for (int i = 0; i < 4; ++i) x[i] = (MODE == 0) ? __builtin_nontemporal_load((const f32x4*)(xsrc + (size_t)row * D + 4 * lane + 256 * i)) : *(const f32x4*)(xsrc + (size_t)row * D + 4 * lane + 256 * i);
    if (MODE == 0 || MODE == 4) { const int t = (row - NCTX) & 4095, pr = t >> 6, pc = t & 63;
#pragma unroll
        for (int i = 0; i < 4; ++i) { const int c = 4 * lane + 256 * i; pe[i] = *(const f32x4*)(PE + (size_t)((i < 2) ? pr : pc) * 512 + (c & 511)); }
    }
    if (MODE != 0) {
#pragma unroll
        for (int i = 0; i < 4; ++i) yw[i] = *(const u32x2*)(Y + (size_t)row * D + 4 * lane + 256 * i);
    }
}
template <int MODE>
__device__ __forceinline__ void rows_process(float* X, bf16_t* H, float* RSTD, int row, int lane, float pes, f32x4 (&x)[4], const u32x2 (&yw)[4], const f32x4 (&pe)[4],
                                             const f32x4 (&gp)[4], const f32x4 (&Gm)[4], const f32x4 (&Sm)[4]) {
    if (MODE == 0 || MODE == 4) {
#pragma unroll
        for (int i = 0; i < 4; ++i) x[i] = x[i] + pe[i] * pes;
    }
    if (MODE != 0) {
        float ss = 0.f; f32x4 y[4];
#pragma unroll
        for (int i = 0; i < 4; ++i) { y[i] = (f32x4){bf_lo(yw[i].x), bf_hi(yw[i].x), bf_lo(yw[i].y), bf_hi(yw[i].y)}; ss += (y[i][0] * y[i][0] + y[i][1] * y[i][1]) + (y[i][2] * y[i][2] + y[i][3] * y[i][3]); }
        ss = wave_sum(ss); const float ry = rsqrtf(ss * (1.0f / 1024.0f) + 1e-6f);
#pragma unroll
        for (int i = 0; i < 4; ++i) x[i] = x[i] + gp[i] * (y[i] * ry);
#pragma unroll
        for (int i = 0; i < 4; ++i) *(f32x4*)(X + (size_t)row * D + 4 * lane + 256 * i) = x[i];
    }
    if (MODE != 3) {
        float ss = 0.f;
#pragma unroll
        for (int i = 0; i < 4; ++i) ss += (x[i][0] * x[i][0] + x[i][1] * x[i][1]) + (x[i][2] * x[i][2] + x[i][3] * x[i][3]);
        ss = wave_sum(ss); const float rx = rsqrtf(ss * (1.0f / 1024.0f) + 1e-6f);
        if (MODE == 2) { if (lane == 0) RSTD[row] = rx; }
        else {
#pragma unroll
            for (int i = 0; i < 4; ++i) { const f32x4 h = (x[i] * rx) * Gm[i] + Sm[i]; u32x2 w; w.x = cvt_pk_bf16(h[0], h[1]); w.y = cvt_pk_bf16(h[2], h[3]);
                *(u32x2*)(H + (size_t)row * D + 4 * lane + 256 * i) = w; }
        }
    }
}
template <int MODE>
__device__ __forceinline__ void phase_rows(const Args& a, const float* modL_res  , int gate_idx, const float* post_g,
                           const float* modL_pre, int sh_idx, int sc_idx, const float* pre_g) {
    const int tid = threadIdx.x, lane = tid & 63, wid = tid >> 6;
    const int gw = blockIdx.x * 8 + wid, nw = gridDim.x * 8;
    float* X = a.out; bf16_t* H = (bf16_t*)(a.ws + WS_H); float* RSTD = (float*)(a.ws + WS_RSTD);
    const bf16_t* Y = (const bf16_t*)(a.ws + WS_Y); const float* PE = (const float*)(a.ws + WS_PE);
    const int rows_per = (TROWS + nw - 1) / nw;
    const int r_lo = gw * rows_per, r_hi = (r_lo + rows_per < TROWS) ? r_lo + rows_per : TROWS;
    int row = r_lo;
    while (row < r_hi) {
        const int cr = (row < NCTX) ? 0 : 1 + ((row - NCTX) >> 12);
        int seg_end = (cr == 0) ? NCTX : NCTX + cr * 4096; if (seg_end > r_hi) seg_end = r_hi;
        const float* xsrc = (MODE == 0 || MODE == 4) ? ((cr == 0) ? a.in[0] : a.in[1] - (size_t)NCTX * D) : (const float*)X;
        const float pes = (cr == 0) ? 0.f : 1.f;
        f32x4 gp[4], Gm[4], Sm[4];
#pragma unroll
        for (int i = 0; i < 4; ++i) { const int c = 4 * lane + 256 * i; gp[i] = (f32x4){0.f, 0.f, 0.f, 0.f}; Gm[i] = gp[i]; Sm[i] = gp[i];
            if (MODE != 0) { gp[i] = *(const f32x4*)(modL_res + (size_t)cr * 6144 + gate_idx * 1024 + c) * *(const f32x4*)(post_g + c); }
            if (MODE == 0 || MODE == 1 || MODE == 4) { Gm[i] = (*(const f32x4*)(modL_pre + (size_t)cr * 6144 + sc_idx * 1024 + c) + 1.0f) * *(const f32x4*)(pre_g + c); Sm[i] = *(const f32x4*)(modL_pre + (size_t)cr * 6144 + sh_idx * 1024 + c); } }
        f32x4 xa[4], xb[4], pa[4], pb[4]; u32x2 ya[4], yb[4];
#pragma unroll
        for (int i = 0; i < 4; ++i) { pa[i] = (f32x4){0.f, 0.f, 0.f, 0.f}; pb[i] = pa[i]; ya[i] = (u32x2){0u, 0u}; yb[i] = ya[i]; }
        rows_load<MODE>(xsrc, Y, PE, row, lane, xa, ya, pa);
        for (; row + 1 < seg_end; row += 2) {
            rows_load<MODE>(xsrc, Y, PE, row + 1, lane, xb, yb, pb);
            rows_process<MODE>(X, H, RSTD, row, lane, pes, xa, ya, pa, gp, Gm, Sm);
            rows_load<MODE>(xsrc, Y, PE, (row + 2 < seg_end) ? row + 2 : row + 1, lane, xa, ya, pa);
            rows_process<MODE>(X, H, RSTD, row + 1, lane, pes, xb, yb, pb, gp, Gm, Sm);
        }
        if (row < seg_end) { rows_process<MODE>(X, H, RSTD, row, lane, pes, xa, ya, pa, gp, Gm, Sm); ++row; }
    }
}

template <bool SRC_IN, bool HAS_Y2>
__device__ __forceinline__ void rows2_load(const float* xsrc, const bf16_t* Y1, const bf16_t* Y2, const float* PE, int row, int lane, f32x4 (&x)[4], u32x2 (&y1)[4], u32x2 (&y2)[4], f32x4 (&pe)[4]) {
#pragma unroll
    for (int i = 0; i < 4; ++i) x[i] = SRC_IN ? __builtin_nontemporal_load((const f32x4*)(xsrc + (size_t)row * D + 4 * lane + 256 * i)) : *(const f32x4*)(xsrc + (size_t)row * D + 4 * lane + 256 * i);
    if (SRC_IN) { const int t = (row - NCTX) & 4095, pr = t >> 6, pc = t & 63;
#pragma unroll
        for (int i = 0; i < 4; ++i) { const int c = 4 * lane + 256 * i; pe[i] = *(const f32x4*)(PE + (size_t)((i < 2) ? pr : pc) * 512 + (c & 511)); }
    }
#pragma unroll
    for (int i = 0; i < 4; ++i) y1[i] = *(const u32x2*)(Y1 + (size_t)row * D + 4 * lane + 256 * i);
    if (HAS_Y2) {
#pragma unroll
        for (int i = 0; i < 4; ++i) y2[i] = __builtin_nontemporal_load((const u32x2*)(Y2 + (size_t)row * D + 4 * lane + 256 * i));
    }
}
__device__ __forceinline__ void rows2_addbranch(f32x4 (&x)[4], const u32x2 (&yw)[4], const f32x4 (&gp)[4]) {
    float ss = 0.f; f32x4 y[4];
#pragma unroll
    for (int i = 0; i < 4; ++i) { y[i] = (f32x4){bf_lo(yw[i].x), bf_hi(yw[i].x), bf_lo(yw[i].y), bf_hi(yw[i].y)}; ss += (y[i][0] * y[i][0] + y[i][1] * y[i][1]) + (y[i][2] * y[i][2] + y[i][3] * y[i][3]); }
    ss = wave_sum(ss); const float ry = rsqrtf(ss * (1.0f / 1024.0f) + 1e-6f);
#pragma unroll
    for (int i = 0; i < 4; ++i) x[i] = x[i] + gp[i] * (y[i] * ry);
}
template <bool SRC_IN, bool HAS_Y2, int OUT>
__device__ __forceinline__ void rows2_process(float* X, bf16_t* H, float* RSTD, int row, int lane, float pes, f32x4 (&x)[4], const u32x2 (&y1)[4], const u32x2 (&y2)[4], const f32x4 (&pe)[4],
                                              const f32x4 (&gp1)[4], const f32x4 (&gp2)[4], const f32x4 (&Gm)[4], const f32x4 (&Sm)[4]) {
    if (SRC_IN) {
#pragma unroll
        for (int i = 0; i < 4; ++i) x[i] = x[i] + pe[i] * pes;
    }
    rows2_addbranch(x, y1, gp1);
    if (HAS_Y2) {
        rows2_addbranch(x, y2, gp2);
#pragma unroll
        for (int i = 0; i < 4; ++i) { if (OUT == 2) __builtin_nontemporal_store(x[i], (f32x4*)(X + (size_t)row * D + 4 * lane + 256 * i)); else *(f32x4*)(X + (size_t)row * D + 4 * lane + 256 * i) = x[i]; }
    }
    if (!HAS_Y2 || OUT == 1) {
        float ss = 0.f;
#pragma unroll
        for (int i = 0; i < 4; ++i) ss += (x[i][0] * x[i][0] + x[i][1] * x[i][1]) + (x[i][2] * x[i][2] + x[i][3] * x[i][3]);
        ss = wave_sum(ss); const float rx = rsqrtf(ss * (1.0f / 1024.0f) + 1e-6f);
        if (HAS_Y2) { if (lane == 0) RSTD[row] = rx; }
        else {
#pragma unroll
            for (int i = 0; i < 4; ++i) { const f32x4 h = (x[i] * rx) * Gm[i] + Sm[i]; u32x2 w; w.x = cvt_pk_bf16(h[0], h[1]); w.y = cvt_pk_bf16(h[2], h[3]);
                *(u32x2*)(H + (size_t)row * D + 4 * lane + 256 * i) = w; }
        }
    }
}
template <bool SRC_IN, bool HAS_Y2, int OUT>
__device__ __forceinline__ void phase_rows2(const Args& a, const float* modL  , const float* post1, const float* post2, const float* pre_g) {
    const int tid = threadIdx.x, lane = tid & 63, wid = tid >> 6;
    const int gw = blockIdx.x * 8 + wid, nw = gridDim.x * 8;
    float* X = a.out; bf16_t* H = (bf16_t*)(a.ws + WS_H); float* RSTD = (float*)(a.ws + WS_RSTD);
    const bf16_t* Y1 = (const bf16_t*)(a.ws + WS_Y1); const bf16_t* Y2 = (const bf16_t*)(a.ws + WS_Y); const float* PE = (const float*)(a.ws + WS_PE);
    const int rows_per = (TROWS + nw - 1) / nw;
    const int r_lo = gw * rows_per, r_hi = (r_lo + rows_per < TROWS) ? r_lo + rows_per : TROWS;
    int row = r_lo;
    while (row < r_hi) {
        const int cr = (row < NCTX) ? 0 : 1 + ((row - NCTX) >> 12);
        int seg_end = (cr == 0) ? NCTX : NCTX + cr * 4096; if (seg_end > r_hi) seg_end = r_hi;
        const float* xsrc = SRC_IN ? ((cr == 0) ? a.in[0] : a.in[1] - (size_t)NCTX * D) : (const float*)X;
        const float pes = (cr == 0) ? 0.f : 1.f;
        f32x4 gp1[4], gp2[4], Gm[4], Sm[4];
#pragma unroll
        for (int i = 0; i < 4; ++i) { const int c = 4 * lane + 256 * i; gp2[i] = (f32x4){0.f, 0.f, 0.f, 0.f}; Gm[i] = gp2[i]; Sm[i] = gp2[i];
            gp1[i] = *(const f32x4*)(modL + (size_t)cr * 6144 + 2 * 1024 + c) * *(const f32x4*)(post1 + c);
            if (HAS_Y2) gp2[i] = *(const f32x4*)(modL + (size_t)cr * 6144 + 5 * 1024 + c) * *(const f32x4*)(post2 + c);
            else { Gm[i] = (*(const f32x4*)(modL + (size_t)cr * 6144 + 4 * 1024 + c) + 1.0f) * *(const f32x4*)(pre_g + c); Sm[i] = *(const f32x4*)(modL + (size_t)cr * 6144 + 3 * 1024 + c); } }
        f32x4 xa[4], xb[4], pa[4], pb[4]; u32x2 y1a[4], y1b[4], y2a[4], y2b[4];
#pragma unroll
        for (int i = 0; i < 4; ++i) { pa[i] = (f32x4){0.f, 0.f, 0.f, 0.f}; pb[i] = pa[i]; y2a[i] = (u32x2){0u, 0u}; y2b[i] = y2a[i]; }
        rows2_load<SRC_IN, HAS_Y2>(xsrc, Y1, Y2, PE, row, lane, xa, y1a, y2a, pa);
        for (; row + 1 < seg_end; row += 2) {
            rows2_load<SRC_IN, HAS_Y2>(xsrc, Y1, Y2, PE, row + 1, lane, xb, y1b, y2b, pb);
            rows2_process<SRC_IN, HAS_Y2, OUT>(X, H, RSTD, row, lane, pes, xa, y1a, y2a, pa, gp1, gp2, Gm, Sm);
            rows2_load<SRC_IN, HAS_Y2>(xsrc, Y1, Y2, PE, (row + 2 < seg_end) ? row + 2 : row + 1, lane, xa, y1a, y2a, pa);
            rows2_process<SRC_IN, HAS_Y2, OUT>(X, H, RSTD, row + 1, lane, pes, xb, y1b, y2b, pb, gp1, gp2, Gm, Sm);
        }
        if (row < seg_end) { rows2_process<SRC_IN, HAS_Y2, OUT>(X, H, RSTD, row, lane, pes, xa, y1a, y2a, pa, gp1, gp2, Gm, Sm); ++row; }
    }
}

constexpr int UROW = 528;
__device__ __forceinline__ void phase_scan(const Args& a, LAS unsigned char* lds) {
    const int tid = threadIdx.x, lane = tid & 63, wid = tid >> 6, q = lane >> 4, cl = lane & 15;
    const int hb = blockIdx.x & 7, cb = hb >> 1;
    const int ewave = (hb & 1) * 128 + wid * 16;
    const int ch = cb * 256 + ewave + cl;
    const bf16_t* REC = (const bf16_t*)(a.ws + WS_REC); const bf16_t* WG = (const bf16_t*)(a.ws + WS_WG);
    float* AGG = (float*)(a.ws + WS_AGG);
    float bA[2], bX[2], c8[2];
#pragma unroll
    for (int d = 0; d < 2; ++d) { bA[d] = -1.44269504089f * a.in[13][d * 1024 + ch]; bX[d] = -1.44269504089f * a.in[15][d * 1024 + ch];
        const float lam = a.in[16][d * 1024 + ch]; c8[d] = -8.0f * log1pf(expf(-lam)) * 1.44269504089f; }
    const int ch8 = tid & 31, rgrp = tid >> 5;
    const int loff = q * 4 * 1024 + ch;
    const int nblk = gridDim.x >> 3;
    for (int ck = blockIdx.x >> 3; ck < NCHUNK; ck += nblk) {
        int cis, nch, seqrow0;
        if (ck < 32) { cis = ck & 1; nch = 2; seqrow0 = (ck >> 1) * 256; }
        else { const int k2 = ck - 32; cis = k2 & 31; nch = 32; seqrow0 = NCTX + (k2 >> 5) * 4096; }
        const int t0 = cis * 128, T = nch * 128, row0 = seqrow0 + t0;
        __syncthreads();
        {
            const bf16_t* rp = REC + (size_t)seqrow0 * 1024 + cb * 256 + ch8 * 8;
            u32x4 wv[11];
            f32x4 cwv[4][2], cbv[2];
#pragma unroll
            for (int h2 = 0; h2 < 2; ++h2) { cbv[h2] = *(const f32x4*)(a.in[11] + cb * 256 + ch8 * 8 + 4 * h2);
#pragma unroll
                for (int k = 0; k < 4; ++k) cwv[k][h2] = *(const f32x4*)(a.in[10] + k * 1024 + cb * 256 + ch8 * 8 + 4 * h2); }
#pragma unroll
            for (int i = 0; i < 11; ++i) { const int tr = t0 + rgrp * 8 - 2 + i; const int trc = tr < 0 ? 0 : (tr >= T ? T - 1 : tr);
                const unsigned msk = (tr < 0 || tr >= T) ? 0u : 0xffffffffu;
                wv[i] = *(const u32x4*)(rp + (size_t)trc * 1024) & msk; }
            float prev[3][8] = {};
#pragma unroll
            for (int i = 0; i < 11; ++i) {
                const u32x4 w0 = wv[i]; float v[8];
                v[0] = bf_lo(w0.x); v[1] = bf_hi(w0.x); v[2] = bf_lo(w0.y); v[3] = bf_hi(w0.y); v[4] = bf_lo(w0.z); v[5] = bf_hi(w0.z); v[6] = bf_lo(w0.w); v[7] = bf_hi(w0.w);
                if (i >= 3) { float u[8];
#pragma unroll
                    for (int j = 0; j < 8; ++j) u[j] = cbv[j >> 2][j & 3] + cwv[0][j >> 2][j & 3] * prev[0][j] + cwv[1][j >> 2][j & 3] * prev[1][j] + cwv[2][j >> 2][j & 3] * prev[2][j] + cwv[3][j >> 2][j & 3] * v[j];
                    u32x4 w; w.x = cvt_pk_bf16(u[0], u[1]); w.y = cvt_pk_bf16(u[2], u[3]); w.z = cvt_pk_bf16(u[4], u[5]); w.w = cvt_pk_bf16(u[6], u[7]);
                    *(LAS u32x4*)(lds + (rgrp * 8 + i - 3) * UROW + ch8 * 16) = w; }
#pragma unroll
                for (int j = 0; j < 8; ++j) { prev[0][j] = prev[1][j]; prev[1][j] = prev[2][j]; prev[2][j] = v[j]; }
            }
        }
        bf16x8 Bf[2][8];
#pragma unroll
        for (int g = 0; g < 2; ++g)
#pragma unroll
            for (int ks = 0; ks < 8; ++ks) Bf[g][ks] = *(const bf16x8*)(WG + ((size_t)((0 * 2 + g) * 4 + cb) * 256 + ewave + cl) * 256 + ks * 32 + q * 8);
        __syncthreads();
#pragma unroll
        for (int dir = 0; dir < 2; ++dir) {
            if (dir == 1) {
#pragma unroll
                for (int g = 0; g < 2; ++g)
#pragma unroll
                    for (int ks = 0; ks < 8; ++ks) Bf[g][ks] = *(const bf16x8*)(WG + ((size_t)((1 * 2 + g) * 4 + cb) * 256 + ewave + cl) * 256 + ks * 32 + q * 8);
            }
            const int p = dir ? 3 - q : q;
            float Atot = 1.f, Btot = 0.f;
            unsigned* const dbase = (unsigned*)(a.ws + (dir ? WS_DBB : WS_DBF)) + (size_t)row0 * 1024;
            f32x4 nA = (f32x4){bA[dir], bA[dir], bA[dir], bA[dir]}, nX = (f32x4){bX[dir], bX[dir], bX[dir], bX[dir]};
            { const int m0 = dir ? 7 : 0;
#pragma unroll
              for (int ks = 0; ks < 8; ++ks) { const bf16x8 Af = *(const LAS bf16x8*)(lds + (16 * m0 + cl) * UROW + (ks * 32 + q * 8) * 2);
                  nA = __builtin_amdgcn_mfma_f32_16x16x32_bf16(Af, Bf[0][ks], nA, 0, 0, 0); nX = __builtin_amdgcn_mfma_f32_16x16x32_bf16(Af, Bf[1][ks], nX, 0, 0, 0); } }
#pragma unroll 1
            for (int mm = 0; mm < 8; ++mm) {
                const int m = dir ? 7 - mm : mm;
                const f32x4 accA = nA, accX = nX;
                { const int mn = (mm < 7) ? (dir ? 6 - mm : mm + 1) : m;
                  nA = (f32x4){bA[dir], bA[dir], bA[dir], bA[dir]}; nX = (f32x4){bX[dir], bX[dir], bX[dir], bX[dir]};
#pragma unroll
                  for (int ks = 0; ks < 8; ++ks) { const bf16x8 Af = *(const LAS bf16x8*)(lds + (16 * mn + cl) * UROW + (ks * 32 + q * 8) * 2);
                      nA = __builtin_amdgcn_mfma_f32_16x16x32_bf16(Af, Bf[0][ks], nA, 0, 0, 0); nX = __builtin_amdgcn_mfma_f32_16x16x32_bf16(Af, Bf[1][ks], nX, 0, 0, 0); } }
                unsigned* const drow = dbase + (size_t)(16 * m) * 1024;
                float aa[4], bb[4];
#pragma unroll
                for (int j = 0; j < 4; ++j) {
                    const float uval = __uint_as_float(((unsigned)*(const LAS unsigned short*)(lds + (16 * m + 4 * q + j) * UROW + (ewave + cl) * 2)) << 16);
                    const float t1 = 1.0f + __builtin_amdgcn_exp2f(accA[j]), t2 = 1.0f + __builtin_amdgcn_exp2f(accX[j]), inv = __builtin_amdgcn_rcpf(t1 * t2);
                    const float av = __builtin_amdgcn_exp2f(c8[dir] * (t2 * inv));
                    const float dv = 1.0f - av, bv = __builtin_amdgcn_sqrtf(fmaxf(dv * (1.0f + av), 0.f)) * ((t1 * inv) * uval);
                    __builtin_nontemporal_store(cvt_pk_bf16(dv, bv), drow + loff + j * 1024);
                    aa[j] = av; bb[j] = bv;
                }
                float Al = 1.f, Bl = 0.f;
#pragma unroll
                for (int jj = 0; jj < 4; ++jj) { const int j = dir ? 3 - jj : jj; Bl = aa[j] * Bl + bb[j]; Al *= aa[j]; }
                const float Ao = xchg16(Al, (q & 1) != 0), Bo = xchg16(Bl, (q & 1) != 0);
                const bool first = !(p & 1);
                const float A1 = first ? Al : Ao, B1 = first ? Bl : Bo, A2 = first ? Ao : Al, B2 = first ? Bo : Bl;
                const float Ap = A1 * A2, Bp = A2 * B1 + B2;
                const float Aq = xchg32(Ap, q >= 2), Bq = xchg32(Bp, q >= 2);
                const bool fp = !(p & 2);
                const float A01 = fp ? Ap : Aq, B01 = fp ? Bp : Bq, A23 = fp ? Aq : Ap, B23 = fp ? Bq : Bp;
                const float At = A01 * A23, Bt = A23 * B01 + B23;
                Btot = At * Btot + Bt; Atot *= At;
            }
            if (q == 0) { float* aA = AGG + (size_t)(dir * NCHUNK + ck) * 1024 + ch; aA[0] = Atot; aA[(size_t)2 * NCHUNK * 1024] = Btot; }
        }
    }
}

__device__ __forceinline__ void phase_apply(const Args& a) {
    const unsigned* DBF = (const unsigned*)(a.ws + WS_DBF); const unsigned* DBB = (const unsigned*)(a.ws + WS_DBB);
    const bf16_t* GACT = (const bf16_t*)(a.ws + WS_GACT); bf16_t* MIX = (bf16_t*)(a.ws + WS_REC); const float* CAR = (const float*)(a.ws + WS_CAR);
    for (int it = blockIdx.x; it < NCHUNK * 2; it += gridDim.x) {
        const int ck = it >> 1, ch = (it & 1) * 512 + threadIdx.x; const size_t o0 = (size_t)ck * 128 * 1024 + ch;
        float hf[128];
        {
            float h = CAR[(size_t)(0 * NCHUNK + ck) * 1024 + ch];
            unsigned w[16], wn[16];
#pragma unroll
            for (int j = 0; j < 16; ++j) { w[j] = __builtin_nontemporal_load(DBF + (o0 + (size_t)j * 1024)); wn[j] = 0u; }
#pragma unroll
            for (int blk = 0; blk < 8; ++blk) {
                if (blk < 7) {
#pragma unroll
                    for (int j = 0; j < 16; ++j) wn[j] = __builtin_nontemporal_load(DBF + (o0 + (size_t)((blk + 1) * 16 + j) * 1024));
                }
#pragma unroll
                for (int j = 0; j < 16; ++j) { h = __builtin_fmaf(-bf_lo(w[j]), h, h) + bf_hi(w[j]); hf[blk * 16 + j] = h; }
#pragma unroll
                for (int j = 0; j < 16; ++j) w[j] = wn[j];
            }
        }
        {
            float h = CAR[(size_t)(1 * NCHUNK + ck) * 1024 + ch];
            unsigned w[16], wn[16]; unsigned short g[16], gn[16];
#pragma unroll
            for (int j = 0; j < 16; ++j) { w[j] = __builtin_nontemporal_load(DBB + (o0 + (size_t)(7 * 16 + j) * 1024)); g[j] = __builtin_nontemporal_load(GACT + (o0 + (size_t)(7 * 16 + j) * 1024)); wn[j] = 0u; gn[j] = 0; }
#pragma unroll
            for (int blk = 7; blk >= 0; --blk) {
                if (blk > 0) {
#pragma unroll
                    for (int j = 0; j < 16; ++j) { wn[j] = __builtin_nontemporal_load(DBB + (o0 + (size_t)((blk - 1) * 16 + j) * 1024)); gn[j] = __builtin_nontemporal_load(GACT + (o0 + (size_t)((blk - 1) * 16 + j) * 1024)); }
                }
#pragma unroll
                for (int j = 15; j >= 0; --j) { h = __builtin_fmaf(-bf_lo(w[j]), h, h) + bf_hi(w[j]);
                    const float mv = (hf[blk * 16 + j] + h) * __uint_as_float(((unsigned)g[j]) << 16);
                    MIX[o0 + (size_t)(blk * 16 + j) * 1024] = (bf16_t)(cvt_pk_bf16(mv, 0.f) & 0xffffu); }
#pragma unroll
                for (int j = 0; j < 16; ++j) { w[j] = wn[j]; g[j] = gn[j]; }
            }
        }
    }
}

__device__ __forceinline__ void phase_carry(const Args& a) {
    const float* AGG = (const float*)(a.ws + WS_AGG); float* CAR = (float*)(a.ws + WS_CAR);
    for (int id = blockIdx.x * 512 + threadIdx.x; id < 24 * 2 * 1024; id += gridDim.x * 512) {
        const int ch = id & 1023, dir = (id >> 10) & 1, s = id >> 11;
        const bool lat = s >= 16; const int nch = lat ? 32 : 2, ck0 = lat ? 32 + (s - 16) * 32 : s * 2;
        float h = lat ? a.in[2][(size_t)((s - 16) * 2 + dir) * 1024 + ch] : 0.f;
        const float* aA = AGG + (size_t)(dir * NCHUNK + ck0) * 1024 + ch; const float* aB = aA + (size_t)2 * NCHUNK * 1024;
        float* cr = CAR + (size_t)(dir * NCHUNK + ck0) * 1024 + ch;
        float A[32], B[32];
#pragma unroll
        for (int k = 0; k < 32; ++k) { const int kk = k < nch ? k : nch - 1; A[k] = aA[(size_t)kk * 1024]; B[k] = aB[(size_t)kk * 1024]; }
        if (dir == 0) {
#pragma unroll
            for (int k = 0; k < 32; ++k) if (k < nch) { cr[(size_t)k * 1024] = h; h = A[k] * h + B[k]; }
        } else {
#pragma unroll
            for (int k = 31; k >= 0; --k) if (k < nch) { cr[(size_t)k * 1024] = h; h = A[k] * h + B[k]; }
        }
        if (!lat) a.out[(size_t)TROWS * 1024 + (size_t)(s * 2 + dir) * 1024 + ch] = h;
    }
}

template <int HALF>
__device__ __forceinline__ void pool_item(const float* X, const float* RSTD, bf16_t* P, int seqrow0, int T, int t0, int c, f32x2 Gm) {
    constexpr int NV = 16 + 2 * HALF;
    f32x2 v[NV];
#pragma unroll
    for (int i = 0; i < NV; ++i) { const int tt = t0 - HALF + i; const int tc = tt < 0 ? 0 : (tt >= T ? T - 1 : tt); const size_t r = (size_t)(seqrow0 + tc);
        const float vm = (tt < 0 || tt >= T) ? 0.f : RSTD[r];
        v[i] = *(const f32x2*)(X + r * D + c) * vm; }
    f32x2 S = (f32x2){0.f, 0.f};
#pragma unroll
    for (int i = 0; i < 2 * HALF; ++i) S += v[i];
#pragma unroll
    for (int j = 0; j < 16; ++j) { const int t = t0 + j; const int lo = (t - HALF) < 0 ? 0 : (t - HALF), hi = (t + HALF) > T ? T : (t + HALF);
        const f32x2 o = Gm * (S * (1.0f / (float)(hi - lo)) - v[j + HALF]);
        *(unsigned*)(P + (size_t)(seqrow0 + t) * D + c) = cvt_pk_bf16(o[0], o[1]);
        if (j < 15) S += v[j + 2 * HALF] - v[j]; }
}
__device__ __forceinline__ void phase_pool(const Args& a) {
    const int tid = threadIdx.x;
    const float* X = a.out; const float* RSTD = (const float*)(a.ws + WS_RSTD); bf16_t* P = (bf16_t*)(a.ws + WS_H);
    const float* MOD1 = (const float*)(a.ws + WS_MOD) + (size_t)9 * 6144;
    const int c = 2 * tid, g = tid >> 7;
    const f32x2 pg = *(const f32x2*)(a.in[24] + c);
    for (int it = blockIdx.x; it < TROWS / 16; it += gridDim.x) {
        const int row0 = it * 16;
        int seqrow0, T, cr;
        if (row0 < NCTX) { seqrow0 = row0 & ~255; T = 256; cr = 0; } else { const int lr = row0 - NCTX; seqrow0 = NCTX + (lr & ~4095); T = 4096; cr = 1 + (lr >> 12); }
        const f32x2 Gm = (*(const f32x2*)(MOD1 + (size_t)cr * 6144 + 1 * 1024 + c) + 1.0f) * pg;
        const int t0 = row0 - seqrow0;
        if (g == 0) pool_item<1>(X, RSTD, P, seqrow0, T, t0, c, Gm);
        else if (g == 1) pool_item<2>(X, RSTD, P, seqrow0, T, t0, c, Gm);
        else if (g == 2) pool_item<4>(X, RSTD, P, seqrow0, T, t0, c, Gm);
        else pool_item<8>(X, RSTD, P, seqrow0, T, t0, c, Gm);
    }
}

constexpr int XNROW = 260;
__device__ __forceinline__ void phase_poolmm(const Args& a, LAS unsigned char* lds) {
    const int tid = threadIdx.x, lane = tid & 63, wid = tid >> 6, q = lane >> 4, cl = lane & 15;
    const int g = blockIdx.x & 3, h = 1 << g;
    const float* X = a.out; const float* RSTD = (const float*)(a.ws + WS_RSTD); bf16_t* Y1 = (bf16_t*)(a.ws + WS_Y1);
    const float* MOD1 = (const float*)(a.ws + WS_MOD) + (size_t)9 * 6144;
    const bf16_t* WP = (const bf16_t*)(a.ws + WS_POOLW);
    LAS float* xnl = (LAS float*)lds;
    LAS unsigned char* pl = lds + 80 * XNROW * 4;
    bf16x8 Bf[2][8];
#pragma unroll
    for (int nt = 0; nt < 2; ++nt)
#pragma unroll
        for (int ks = 0; ks < 8; ++ks) Bf[nt][ks] = *(const bf16x8*)(WP + ((size_t)(g * 256 + wid * 32 + nt * 16 + cl)) * 256 + ks * 32 + q * 8);
    float pb[2], ps[2];
#pragma unroll
    for (int nt = 0; nt < 2; ++nt) { const int chn = g * 256 + wid * 32 + nt * 16 + cl; pb[nt] = a.in[27][chn]; ps[nt] = a.in[28][chn]; }
    const int c2 = tid & 127, tq = tid >> 7;
    const f32x2 pg = *(const f32x2*)(a.in[24] + g * 256 + 2 * c2);
    const int srow = tid >> 6, sc4 = tid & 63;
    const int nblk = gridDim.x >> 2;
    f32x4 xv[10]; float vmv[10];
#define PM_ISSUE(ttx) do { const int r0_ = (ttx) * 64; int s0_, s1_; if (r0_ < NCTX) { s0_ = r0_ & ~255; s1_ = s0_ + 256; } else { const int lr_ = r0_ - NCTX; s0_ = NCTX + (lr_ & ~4095); s1_ = s0_ + 4096; } \
        _Pragma("unroll") for (int i = 0; i < 10; ++i) { const int r = r0_ - 8 + srow + 8 * i; const int rc = r < s0_ ? s0_ : (r >= s1_ ? s1_ - 1 : r); \
            vmv[i] = (r < s0_ || r >= s1_) ? 0.f : RSTD[rc]; xv[i] = *(const f32x4*)(X + (size_t)rc * D + g * 256 + sc4 * 4); } } while (0)
    int tt = blockIdx.x >> 2;
    if (tt < TROWS / 64) PM_ISSUE(tt);
    for (; tt < TROWS / 64; tt += nblk) {
        const int r0 = tt * 64; int s0, s1, cr;
        if (r0 < NCTX) { s0 = r0 & ~255; s1 = s0 + 256; cr = 0; } else { const int lr = r0 - NCTX; s0 = NCTX + (lr & ~4095); s1 = s0 + 4096; cr = 1 + (lr >> 12); }
        __syncthreads();
#pragma unroll
        for (int i = 0; i < 10; ++i) *(LAS f32x4*)(xnl + (srow + 8 * i) * XNROW + sc4 * 4) = xv[i] * vmv[i];
        __syncthreads();
        {
            const f32x2 Gm = (*(const f32x2*)(MOD1 + (size_t)cr * 6144 + 1 * 1024 + g * 256 + 2 * c2) + 1.0f) * pg;
            const int tl0 = tq * 16;
            f32x2 S = (f32x2){0.f, 0.f};
            for (int d = -h; d < h; ++d) S += *(const LAS f32x2*)(xnl + (tl0 + 8 + d) * XNROW + 2 * c2);
#pragma unroll 4
            for (int j = 0; j < 16; ++j) { const int tl = tl0 + j, t = r0 + tl; const int lo = (t - h) < s0 ? s0 : (t - h), hi = (t + h) > s1 ? s1 : (t + h);
                const f32x2 xc = *(const LAS f32x2*)(xnl + (tl + 8) * XNROW + 2 * c2);
                const f32x2 o = Gm * (S * (1.0f / (float)(hi - lo)) - xc);
                *(LAS unsigned*)(pl + tl * UROW + c2 * 4) = cvt_pk_bf16(o[0], o[1]);
                S += *(const LAS f32x2*)(xnl + (tl + 8 + h) * XNROW + 2 * c2) - *(const LAS f32x2*)(xnl + (tl + 8 - h) * XNROW + 2 * c2); }
        }
        { const int ttn = (tt + nblk < TROWS / 64) ? tt + nblk : tt; PM_ISSUE(ttn); }
        __syncthreads();
#pragma unroll 1
        for (int m = 0; m < 4; ++m) {
            f32x4 acc[2] = {(f32x4){0.f, 0.f, 0.f, 0.f}, (f32x4){0.f, 0.f, 0.f, 0.f}};
#pragma unroll
            for (int ks = 0; ks < 8; ++ks) { const bf16x8 Af = *(const LAS bf16x8*)(pl + (16 * m + cl) * UROW + (ks * 32 + q * 8) * 2);
                acc[0] = __builtin_amdgcn_mfma_f32_16x16x32_bf16(Af, Bf[0][ks], acc[0], 0, 0, 0); acc[1] = __builtin_amdgcn_mfma_f32_16x16x32_bf16(Af, Bf[1][ks], acc[1], 0, 0, 0); }
            bf16_t* const yrow = Y1 + (size_t)(r0 + 16 * m) * 1024;
#pragma unroll
            for (int nt = 0; nt < 2; ++nt)
#pragma unroll
                for (int j = 0; j < 4; ++j) yrow[(4 * q + j) * 1024 + g * 256 + wid * 32 + nt * 16 + cl] = (bf16_t)(cvt_pk_bf16((acc[nt][j] + pb[nt]) * ps[nt], 0.f) & 0xffffu);
        }
    }
#undef PM_ISSUE
}

__global__ void __launch_bounds__(512, 2) mk_fwd(Args a) {
    extern __shared__ __attribute__((aligned(16))) unsigned char lds_raw[];
    LAS unsigned char* lds = (LAS unsigned char*)lds_raw;
    unsigned char* ws = a.ws;
    const float* MOD0 = (const float*)(ws + WS_MOD); const float* MOD1 = MOD0 + (size_t)9 * 6144;
    bf16_t* Hb = (bf16_t*)(ws + WS_H); bf16_t* Yb = (bf16_t*)(ws + WS_Y); bf16_t* Bb = (bf16_t*)(ws + WS_B);
    const int lo = a.ph_lo, hi = a.ph_hi;
    volatile LAS unsigned* bst = (volatile LAS unsigned*)(lds + LDS_BYTES - 16);
    if (threadIdx.x < 4) bst[threadIdx.x] = 0u;
    __syncthreads();
    XcdBarrier bar; bar.bar = (unsigned*)(ws + WS_BAR); bar.x = 0; bar.st = bst;
    if (hi - lo > 1) bar = xcd_barrier_post((unsigned*)(ws + WS_BAR), bst);
    if (hi > NPH) cg::this_grid().sync();
#define GRID_BAR() xcd_barrier(bar)
#define IN(k) ((PH_MASK & (1 << (k))) && lo <= (k) && (k) < hi)
#define SEAM(k) do { if (lo <= (k) && (k) + 1 < hi) GRID_BAR(); } while (0)
#define REPS(k) (((REP_MASK) >> (k)) & 1 ? 2 : 1)
#define RUN_GEMM(k, tl) do { for (int rep_ = 0; rep_ < REPS(k); ++rep_) { pg8::StaticOrder S; S.init(g.M, g.N, g.K, (int)gridDim.x, (int)blockIdx.x, tl); pg8::gemm_phase(lds, g, S, E); if (rep_ + 1 < REPS(k)) GRID_BAR(); } } while (0)
#define RUN(k, call) do { if (IN(k)) for (int rep_ = 0; rep_ < REPS(k); ++rep_) { call; if (rep_ + 1 < REPS(k)) GRID_BAR(); } SEAM(k); } while (0)
    float* const PARTp = (float*)(ws + WS_H);
    RUN(0, phase_prologue(a, lds));
    RUN(1, phase_rows<0>(a, nullptr, 0, nullptr, MOD0, 0, 1, a.in[7]));
    if (IN(2)) { pg8::Gemm g{Hb, (const bf16_t*)(ws + WS_WIN0), TROWS, 2048, 1024, 1024, 0}; pg8::Epi E{0, (bf16_t*)(ws + WS_GACT), (bf16_t*)(ws + WS_REC), nullptr, nullptr, nullptr, 16}; RUN_GEMM(2, 0); }
    SEAM(2);
    RUN(3, phase_scan(a, lds));
    RUN(4, phase_carry(a));
    RUN(5, phase_apply(a));
    if (IN(6)) { pg8::Gemm g{(const bf16_t*)(ws + WS_REC), (const bf16_t*)(ws + WS_WOUT0), TROWS, 1024, 1024, 1024, 0}; pg8::Epi E{1, (bf16_t*)(ws + WS_Y1), nullptr, nullptr, nullptr, nullptr, 16}; RUN_GEMM(6, 0); }
    SEAM(6);
    if (IN(7)) phase_rows2<true, false, 0>(a, MOD0, a.in[8], nullptr, a.in[18]);
    SEAM(7);
    if (IN(8)) { pg8::Gemm g{Hb, (const bf16_t*)(ws + WS_FIN0), TROWS, 2 * DFF, 1024, 1024, 0}; pg8::Epi E{2, Bb, nullptr, nullptr, nullptr, nullptr, 16}; RUN_GEMM(8, 0); }
    SEAM(8);
    if (IN(9)) { pg8::Gemm g{Bb, (const bf16_t*)(ws + WS_FOUT0), TROWS, 1024, DFF, DFF, 0}; pg8::Epi E{1, Yb, nullptr, nullptr, nullptr, PARTp, 44}; RUN_GEMM(9, 1); }
    SEAM(9);
    if (IN(10)) tail_reduce(PARTp, Yb);
    SEAM(10);
    if (IN(11)) phase_rows2<true, true, 1>(a, MOD0, a.in[8], a.in[19], nullptr);
    SEAM(11);
    RUN(12, phase_poolmm(a, lds));
    if (IN(14)) phase_rows2<false, false, 0>(a, MOD1, a.in[25], nullptr, a.in[29]);
    SEAM(14);
    if (IN(15)) { pg8::Gemm g{Hb, (const bf16_t*)(ws + WS_FIN1), TROWS, 2 * DFF, 1024, 1024, 0}; pg8::Epi E{2, Bb, nullptr, nullptr, nullptr, nullptr, 16}; RUN_GEMM(15, 0); }
    SEAM(15);
    if (IN(16)) { pg8::Gemm g{Bb, (const bf16_t*)(ws + WS_FOUT1), TROWS, 1024, DFF, DFF, 0}; pg8::Epi E{1, Yb, nullptr, nullptr, nullptr, PARTp, 44}; RUN_GEMM(16, 1); }
    SEAM(16);
    if (IN(17)) tail_reduce(PARTp, Yb);
    SEAM(17);
    if (IN(18)) phase_rows2<false, true, 2>(a, MOD1, a.in[25], a.in[30], nullptr);
#undef RUN
#undef GRID_BAR
#undef IN
#undef SEAM
#undef RUN_GEMM
#undef REPS
}

extern "C" void kernel_launch(void* const* d_in, const int* in_sizes, int n_in, void* d_out, int out_size, void* d_ws, size_t ws_size, hipStream_t stream) {
    static int grid = 0;
    if (grid == 0) {
        if (n_in != 33 || ws_size < WS_END) { fprintf(stderr, "kernel_launch: need 33 inputs and %zu bytes of workspace; got %d, %zu\n", (size_t)WS_END, n_in, ws_size); grid = -1; return; }
        int dev = 0, cus = 0, per_cu = 0;
        hipGetDevice(&dev); hipDeviceGetAttribute(&cus, hipDeviceAttributeMultiprocessorCount, dev);
        if (hipFuncSetAttribute((const void*)mk_fwd, hipFuncAttributeMaxDynamicSharedMemorySize, LDS_BYTES) != hipSuccess) { fprintf(stderr, "kernel_launch: hipFuncSetAttribute failed\n"); grid = -1; return; }
        if (hipOccupancyMaxActiveBlocksPerMultiprocessor(&per_cu, (const void*)mk_fwd, 512, LDS_BYTES) != hipSuccess || per_cu < 1) { fprintf(stderr, "kernel_launch: occupancy query says %d\n", per_cu); per_cu = 1; }
        (void)hipGetLastError();
        grid = cus;
    }
    if (grid < 0) return;
    if (hipMemsetAsync((char*)d_ws + WS_BAR, 0, WS_BAR_BYTES, stream) != hipSuccess) { fprintf(stderr, "kernel_launch: memset of the barrier words failed\n"); return; }
    Args a{};
    for (int i = 0; i < 33; ++i) a.in[i] = (const float*)d_in[i];
    a.out = (float*)d_out; a.ws = (unsigned char*)d_ws;
#if MK_PER_PHASE
    for (int ph = 0; ph < NPH; ++ph) { a.ph_lo = ph; a.ph_hi = ph + 1; hipLaunchKernelGGL(mk_fwd, dim3(grid), dim3(512), LDS_BYTES, stream, a); }
#else
    a.ph_lo = 0; a.ph_hi = NPH;
    void* args[] = {&a};
    hipError_t e = hipLaunchCooperativeKernel((const void*)mk_fwd, dim3(grid), dim3(512), args, LDS_BYTES, stream);
    if (e != hipSuccess) fprintf(stderr, "cooperative launch failed: %s (grid %d)\n", hipGetErrorString(e), grid);
#endif
}
```

```cpp
#include <hip/hip_runtime.h>
#include <hip/hip_cooperative_groups.h>
#include <cstdio>
namespace cg = cooperative_groups;

#ifndef PH_MASK
#define PH_MASK 0x7FFFF
#endif
#ifndef REP_MASK
#define REP_MASK 0x0
#endif
#ifndef MK_PER_PHASE
#define MK_PER_PHASE 0
#endif

#define LAS __attribute__((address_space(3)))
typedef unsigned short bf16_t;
typedef short bf16x8 __attribute__((ext_vector_type(8)));
typedef float f32x4 __attribute__((ext_vector_type(4)));
typedef float f32x2 __attribute__((ext_vector_type(2)));
typedef unsigned u32x4 __attribute__((ext_vector_type(4)));
typedef unsigned u32x2 __attribute__((ext_vector_type(2)));

constexpr int D = 1024, DFF = 2816, NCTX = 16 * 256, NLAT = 8 * 4096, TROWS = NCTX + NLAT;
constexpr int NCHUNK = TROWS / 128;
constexpr int LDS_BYTES = 135168 + 16;
constexpr int NPH = 19;

constexpr size_t al256(size_t x) { return (x + 255) & ~(size_t)255; }
constexpr size_t WS_BAR = 0;
constexpr size_t WS_BAR_BYTES = 3456 * 4;
constexpr size_t WS_MOD = al256(WS_BAR + WS_BAR_BYTES);
constexpr size_t WS_PE = al256(WS_MOD + 2 * 9 * 6144 * 4);
constexpr size_t WS_RSTD = al256(WS_PE + 64 * 512 * 4);
constexpr size_t WS_AGG = al256(WS_RSTD + (size_t)TROWS * 4);
constexpr size_t WS_CAR = al256(WS_AGG + (size_t)2 * 2 * NCHUNK * 1024 * 4);
constexpr size_t WS_WIN0 = al256(WS_CAR + (size_t)2 * NCHUNK * 1024 * 4);
constexpr size_t WS_WOUT0 = WS_WIN0 + (size_t)2048 * 1024 * 2;
constexpr size_t WS_FIN0 = WS_WOUT0 + (size_t)1024 * 1024 * 2;
constexpr size_t WS_FOUT0 = WS_FIN0 + (size_t)5632 * 1024 * 2;
constexpr size_t WS_FIN1 = WS_FOUT0 + (size_t)1024 * 2816 * 2;
constexpr size_t WS_FOUT1 = WS_FIN1 + (size_t)5632 * 1024 * 2;
constexpr size_t WS_POOLW = WS_FOUT1 + (size_t)1024 * 2816 * 2;
constexpr size_t WS_WG = WS_POOLW + (size_t)1024 * 256 * 2;
constexpr size_t MIB = 1024 * 1024;
constexpr size_t WS_BASE = al256(WS_WG + (size_t)16 * 256 * 256 * 2);
constexpr size_t WS_H = WS_BASE;
constexpr size_t WS_Y = WS_BASE + 72 * MIB;
constexpr size_t WS_Y1 = WS_BASE + 144 * MIB;
constexpr size_t WS_B = WS_BASE + 216 * MIB;
constexpr size_t WS_DBF = WS_BASE;
constexpr size_t WS_DBB = WS_BASE + 144 * MIB;
constexpr size_t WS_GACT = WS_BASE + 288 * MIB;
constexpr size_t WS_REC = WS_BASE + 360 * MIB;
constexpr size_t WS_END = WS_BASE + 432 * MIB;

struct Args { const float* in[33]; float* out; unsigned char* ws; int ph_lo, ph_hi; };

__device__ __forceinline__ unsigned cvt_pk_bf16(float lo, float hi) { unsigned r; asm volatile("v_cvt_pk_bf16_f32 %0, %1, %2" : "=v"(r) : "v"(lo), "v"(hi)); return r; }
__device__ __forceinline__ float bf_lo(unsigned w) { return __uint_as_float(w << 16); }
__device__ __forceinline__ float bf_hi(unsigned w) { return __uint_as_float(w & 0xffff0000u); }
__device__ __forceinline__ float sigmoid_f(float x) { return __builtin_amdgcn_rcpf(1.0f + __builtin_amdgcn_exp2f(-1.44269504089f * x)); }
__device__ __forceinline__ float silu_f(float x) { return x * sigmoid_f(x); }
__device__ __forceinline__ float gelu_tanh_f(float x) { const float z = x + 0.044715f * x * x * x; return x * __builtin_amdgcn_rcpf(1.0f + __builtin_amdgcn_exp2f(-2.0f * 0.7978845608f * 1.44269504089f * z)); }
__device__ __forceinline__ float xchg16(float x, bool oddrow) { const u32x2 r = __builtin_amdgcn_permlane16_swap(__float_as_uint(x), __float_as_uint(x), false, false); return __uint_as_float(oddrow ? r.x : r.y); }
__device__ __forceinline__ float xchg32(float x, bool upper) { const u32x2 r = __builtin_amdgcn_permlane32_swap(__float_as_uint(x), __float_as_uint(x), false, false); return __uint_as_float(upper ? r.x : r.y); }
__device__ __forceinline__ float wave_sum(float v) {
#pragma unroll
    for (int o = 32; o >= 1; o >>= 1) v += __shfl_xor(v, o);
    return v;
}

#define XB_TMO      128
#define XB_XCNT(j)  (256  + 64 * (j))
#define XB_XSUB(j)  (1280 + 64 * (j))
#define XB_XGEN(j)  (2304 + 64 * (j))
#define XB_TOP      3328
#define XB_TOPGEN   3392
#define XCD_BAR_WORDS 3456
#define XB_SPIN_CAP (1u << 22)
__device__ __forceinline__ unsigned xb_ld(unsigned* p)              { return __hip_atomic_load(p, __ATOMIC_RELAXED, __HIP_MEMORY_SCOPE_AGENT); }
__device__ __forceinline__ unsigned xb_add(unsigned* p, unsigned v) { return __hip_atomic_fetch_add(p, v, __ATOMIC_RELAXED, __HIP_MEMORY_SCOPE_AGENT); }
__device__ __forceinline__ unsigned xb_xcc_id() { return (unsigned)__builtin_amdgcn_s_getreg((3 << 11) | 20) & 0xFu; }
#define XB_SPIN(cond, bar) do { unsigned _sp = 0; while (cond) { __builtin_amdgcn_s_sleep(1); \
    if ((++_sp & 255u) == 0u) { if (xb_ld(&(bar)[XB_TMO])) break; if (_sp > XB_SPIN_CAP) { atomicAdd(&(bar)[XB_TMO], 1u); break; } } } } while (0)
struct XcdBarrier { unsigned* bar; unsigned x; volatile LAS unsigned* st; };
__device__ __forceinline__ XcdBarrier xcd_barrier_post(unsigned* bar, volatile LAS unsigned* st) {
    XcdBarrier b; b.bar = bar; b.x = xb_xcc_id(); b.st = st;
    if (threadIdx.x == 0) (void)xb_add(&bar[XB_XCNT(b.x)], 1u);
    return b;
}
__device__ __forceinline__ void xcd_barrier_complete(unsigned* bar, unsigned x, unsigned& nloc, unsigned& nx) {
    const unsigned G = gridDim.x * gridDim.y * gridDim.z;
    unsigned sum, cnt, mine, sp = 0u;
    for (;;) {
        sum = 0u; cnt = 0u; mine = 0u;
#pragma unroll
        for (unsigned j = 0; j < 16; ++j) { const unsigned c = xb_ld(&bar[XB_XCNT(j)]); sum += c; cnt += (c > 0u) ? 1u : 0u; mine = (j == x) ? c : mine; }
        if (sum == G) break;
        __builtin_amdgcn_s_sleep(1);
        if ((++sp & 255u) == 0u) { if (xb_ld(&bar[XB_TMO])) break; if (sp > XB_SPIN_CAP) { atomicAdd(&bar[XB_TMO], 1u); break; } }
    }
    nloc = mine > 0u ? mine : 1u; nx = cnt > 0u ? cnt : 1u;
}
__device__ __forceinline__ void xcd_barrier(const XcdBarrier& b) {
    asm volatile("s_waitcnt vmcnt(0)" ::: "memory");
    __syncthreads();
    if (threadIdx.x == 0) {
        unsigned* bar = b.bar;
        __builtin_amdgcn_s_waitcnt(0);
        unsigned nloc = b.st[0], nx = b.st[1];
        if (nloc == 0u) { xcd_barrier_complete(bar, b.x, nloc, nx); b.st[0] = nloc; b.st[1] = nx; }
        const unsigned old = xb_add(&bar[XB_XSUB(b.x)], 1u);
        const unsigned gen = old / nloc;
        if (old + 1u == (gen + 1u) * nloc) {
            __builtin_amdgcn_fence(__ATOMIC_RELEASE, "agent");
            asm volatile("s_waitcnt vmcnt(0)" ::: "memory");
            const unsigned og = xb_add(&bar[XB_TOP], 1u);
            const unsigned tg = og / nx;
            if (og + 1u == (tg + 1u) * nx) xb_add(&bar[XB_TOPGEN], 1u);
            else XB_SPIN(xb_ld(&bar[XB_TOPGEN]) == tg, bar);
            __builtin_amdgcn_fence(__ATOMIC_ACQUIRE, "agent");
            xb_add(&bar[XB_XGEN(b.x)], 1u);
            asm volatile("s_waitcnt vmcnt(0)" ::: "memory");
        } else {
            XB_SPIN(xb_ld(&bar[XB_XGEN(b.x)]) == gen, bar);
            __builtin_amdgcn_fence(__ATOMIC_ACQUIRE, "agent");
            asm volatile("s_waitcnt vmcnt(0)" ::: "memory");
        }
    }
    __syncthreads();
}

namespace pg8 {
constexpr int BM = 256, BK = 64, HALF = 128, HTB = HALF * BK * 2, STAGE_BYTES = 8 * HTB, NXCD = 8, WGM = 8;
__host__ __device__ __forceinline__ int lds_byte(int r, int c) { const int st = (r >> 4) * 2 + (c >> 5), rr = r & 15, cc = c & 31, ob = rr * 64 + cc * 2; return st * 1024 + (ob ^ (((ob >> 9) & 1) << 5)); }
__host__ __device__ __forceinline__ void stage_rc(int b, int& R, int& C) { const int st = b / 1024, sb = b % 1024, swz = sb ^ (((sb >> 9) & 1) << 5); R = (st >> 1) * 16 + swz / 64; C = (st & 1) * 32 + (swz % 64) / 2; }
__host__ __device__ __forceinline__ int perm32(int rho) { const int n = rho >> 4, i = rho & 15; return 8 * (i >> 2) + 4 * n + (i & 3); }
struct Unit { int pm, pn, kt0, nkt; };
struct Gemm { const bf16_t* A; const bf16_t* Bt; int M, N, K, lda, diag; };
struct StaticOrder {
    int nM, nN, nwg, G, c, ntfull, tail, rev;
    __device__ __forceinline__ void init(int M, int N, int K, int G_, int c_, int tail_) { nM = M / BM; nN = N / BM; G = G_; c = c_; ntfull = K / BK; rev = tail_ >> 1; tail_ &= 1; tail = (tail_ && G_ == 256 && nM == 144 && nN == 4 && ntfull == 44) ? 1 : 0; if (tail) nM = 128; nwg = nM * nN; }
    __device__ __forceinline__ bool next(int i, Unit& u) const {
        if (tail && i == 2) { const int tile = c >> 2, ks = c & 3; u.pm = 128 + (tile >> 2); u.pn = tile & 3; u.kt0 = ks < 2 ? ks * 12 : 24 + (ks - 2) * 10; u.nkt = ks < 2 ? 12 : 10; return true; }
        long L = (long)i * G + c; if (L >= nwg) return false; if (rev) L = nwg - 1 - L;
        int wgid = (int)L; { const int q = nwg / NXCD, r = nwg % NXCD, xcd = wgid % NXCD, off = wgid / NXCD; wgid = (xcd < r ? xcd * (q + 1) : r * (q + 1) + (xcd - r) * q) + off; }
        const int nig = WGM * nN, gid = wgid / nig, fm = gid * WGM, gsz = (nM - fm) < WGM ? (nM - fm) : WGM;
        u.pm = fm + ((wgid % nig) % gsz); u.pn = (wgid % nig) / gsz; u.kt0 = 0; u.nkt = ntfull; return true;
    }
};
struct Epi {
    int mode;
    bf16_t* O0; bf16_t* O1; const float* pb; const float* ps; float* PART; int ntfull;
    __device__ __forceinline__ void operator()(const f32x4 (&acc)[2][2][4][2], const Unit& u, int wr, int wc, int fr, int fq) const {
        const int row0 = u.pm * BM + wr * 64 + fr;
        if (u.nkt != ntfull) {
            const int ks = u.kt0 == 0 ? 0 : (u.kt0 == 12 ? 1 : (u.kt0 == 24 ? 2 : 3)), tile = (u.pm - 128) * 4 + u.pn;
            float* dst = PART + (size_t)(ks * 64 + tile) * 65536 + (size_t)(wr * 64 + fr) * 256 + wc * 32 + 8 * fq;
#pragma unroll
            for (int ai = 0; ai < 2; ++ai)
#pragma unroll
                for (int m = 0; m < 4; ++m)
#pragma unroll
                    for (int bj = 0; bj < 2; ++bj)
#pragma unroll
                        for (int n = 0; n < 2; ++n) *(f32x4*)(dst + (size_t)(ai * HALF + m * 16) * 256 + bj * HALF + 4 * n) = acc[ai][bj][m][n];
            return;
        }
        if (mode == 2) {
            const int col0 = u.pn * 128 + wc * 32 + 8 * fq;
#pragma unroll
            for (int ai = 0; ai < 2; ++ai)
#pragma unroll
                for (int m = 0; m < 4; ++m) {
                    bf16_t* rowp = O0 + (size_t)(row0 + ai * HALF + m * 16) * DFF + col0;
                    const f32x4 g0 = acc[ai][0][m][0], g1 = acc[ai][0][m][1], u0 = acc[ai][1][m][0], u1 = acc[ai][1][m][1];
                    u32x4 w;
#define SWG(gv, uv) (((gv) * (uv)) * __builtin_amdgcn_rcpf(1.0f + __builtin_amdgcn_exp2f(gv)))
                    w.x = cvt_pk_bf16(SWG(g0[0], u0[0]), SWG(g0[1], u0[1])); w.y = cvt_pk_bf16(SWG(g0[2], u0[2]), SWG(g0[3], u0[3]));
                    w.z = cvt_pk_bf16(SWG(g1[0], u1[0]), SWG(g1[1], u1[1])); w.w = cvt_pk_bf16(SWG(g1[2], u1[2]), SWG(g1[3], u1[3]));
#undef SWG
                    *(u32x4*)rowp = w;
                }
        } else {
            bf16_t* base = O0; int colt = u.pn * BM; bool act = false;
            if (mode == 0) { if (u.pn >= 4) { base = O1; colt -= 1024; } else act = true; }
            const int col0 = colt + wc * 32 + 8 * fq;
            f32x4 bv[2][2], sv[2][2];
#pragma unroll
            for (int bj = 0; bj < 2; ++bj)
#pragma unroll
                for (int n = 0; n < 2; ++n) {
                    if (mode == 3) { bv[bj][n] = *(const f32x4*)(pb + col0 + bj * HALF + 4 * n); sv[bj][n] = *(const f32x4*)(ps + col0 + bj * HALF + 4 * n); }
                    else { bv[bj][n] = (f32x4){0.f, 0.f, 0.f, 0.f}; sv[bj][n] = (f32x4){1.f, 1.f, 1.f, 1.f}; }
                }
#pragma unroll
            for (int ai = 0; ai < 2; ++ai)
#pragma unroll
                for (int m = 0; m < 4; ++m) {
                    bf16_t* rowp = base + (size_t)(row0 + ai * HALF + m * 16) * D + col0;
#pragma unroll
                    for (int bj = 0; bj < 2; ++bj) {
                        f32x4 v0 = (acc[ai][bj][m][0] + bv[bj][0]) * sv[bj][0], v1 = (acc[ai][bj][m][1] + bv[bj][1]) * sv[bj][1];
                        if (act) {
#pragma unroll
                            for (int j = 0; j < 4; ++j) { v0[j] = gelu_tanh_f(v0[j]); v1[j] = gelu_tanh_f(v1[j]); }
                        }
                        u32x4 w; w.x = cvt_pk_bf16(v0[0], v0[1]); w.y = cvt_pk_bf16(v0[2], v0[3]); w.z = cvt_pk_bf16(v1[0], v1[1]); w.w = cvt_pk_bf16(v1[2], v1[3]);
                        *(u32x4*)(rowp + bj * HALF) = w;
                    }
                }
        }
    }
};

__device__ __forceinline__ void gemm_phase(LAS unsigned char* lds, const Gemm g, const StaticOrder& S, const Epi& E) {
    const int tid = threadIdx.x, wid = __builtin_amdgcn_readfirstlane(tid >> 6), lane = tid & 63, wr = wid >> 2, wc = wid & 3, fr = lane & 15, fq = lane >> 4;
    const int K = g.K, lda = g.lda;
    unsigned voffA[2], voffB[2];
#pragma unroll
    for (int i = 0; i < 2; ++i) { int R, C; stage_rc(tid * 16 + i * 8192, R, C); const int Rb = (R & ~31) + perm32(R & 31);
        voffA[i] = (unsigned)(R * lda + C) * 2u; voffB[i] = (unsigned)(Rb * K + C) * 2u; }
    const size_t kstep = (size_t)(BK * 2);
    const size_t hstepA = (size_t)HALF * lda * 2, hstepB = (size_t)HALF * K * 2;
    const size_t tstepA = 2 * hstepA, tstepB = 2 * hstepB;
    const size_t dstep = g.diag ? (size_t)K * 2 : 0;
    const unsigned ldsw = (unsigned)wid * 1024u;
    const int aoff = lds_byte(wr * 64 + fr, fq * 8), boff = lds_byte(wc * 32 + fr, fq * 8);
#define PG8_SA(b, h) (((b) * 2 + (h)) * HTB)
#define PG8_SB(b, h) ((4 + (b) * 2 + (h)) * HTB)
#define PG8_STAGE(bufoff, gbase, voff) do { _Pragma("unroll") for (int _i = 0; _i < 2; ++_i) \
        __builtin_amdgcn_global_load_lds((const unsigned*)((const char*)(gbase) + (voff)[_i]), (LAS unsigned*)(lds + (bufoff) + ldsw + _i * 8192), 16, 0, 0); } while (0)
#define PG8_LDA(dst, b, h) do { _Pragma("unroll") for (int m = 0; m < 4; ++m) _Pragma("unroll") for (int k = 0; k < 2; ++k) dst[m][k] = *(const LAS bf16x8*)(lds + PG8_SA(b, h) + aoff + m * 2048 + k * 1024); } while (0)
#define PG8_LDB(dst, b, h) do { _Pragma("unroll") for (int n = 0; n < 2; ++n) _Pragma("unroll") for (int k = 0; k < 2; ++k) dst[n][k] = *(const LAS bf16x8*)(lds + PG8_SB(b, h) + boff + n * 2048 + k * 1024); } while (0)
#define PG8_MMA(ai, bj, At, Bt) do { __builtin_amdgcn_s_setprio(1); _Pragma("unroll") for (int m = 0; m < 4; ++m) _Pragma("unroll") for (int n = 0; n < 2; ++n) _Pragma("unroll") for (int k = 0; k < 2; ++k) \
        acc[ai][bj][m][n] = __builtin_amdgcn_mfma_f32_16x16x32_bf16(Bt[n][k], At[m][k], acc[ai][bj][m][n], 0, 0, 0); __builtin_amdgcn_s_setprio(0); } while (0)
#define PG8_WAIT_V(n) asm volatile("s_waitcnt vmcnt(" #n ")" ::: "memory")
#define PG8_WAIT_L(n) asm volatile("s_waitcnt lgkmcnt(" #n ")" ::: "memory")
#define PG8_BAR __builtin_amdgcn_s_barrier()
#define PG8_SCHED __builtin_amdgcn_sched_barrier(0)
    Unit cur, nxt; int ui = 0;
    if (!S.next(0, cur)) return;
    f32x4 acc[2][2][4][2];
#pragma unroll
    for (int a = 0; a < 2; ++a)
#pragma unroll
        for (int b = 0; b < 2; ++b)
#pragma unroll
            for (int m = 0; m < 4; ++m)
#pragma unroll
                for (int n = 0; n < 2; ++n) acc[a][b][m][n] = (f32x4){0.f, 0.f, 0.f, 0.f};
    bf16x8 At[4][2], B0[2][2], B1[2][2];
    const char* cA = (const char*)g.A + (size_t)cur.pm * tstepA + (size_t)cur.pn * dstep + (size_t)cur.kt0 * kstep; const char* cB = (const char*)g.Bt + (size_t)cur.pn * tstepB + (size_t)cur.kt0 * kstep;
    PG8_STAGE(PG8_SB(0, 0), cB, voffB); PG8_STAGE(PG8_SB(0, 1), cB + hstepB, voffB); PG8_STAGE(PG8_SA(0, 0), cA, voffA); PG8_STAGE(PG8_SA(0, 1), cA + hstepA, voffA);
    if (wr == 1) PG8_BAR;
    PG8_WAIT_V(2); PG8_BAR;
    PG8_STAGE(PG8_SB(1, 0), cB + kstep, voffB); PG8_STAGE(PG8_SA(1, 0), cA + kstep, voffA); PG8_STAGE(PG8_SB(1, 1), cB + hstepB + kstep, voffB);
    PG8_WAIT_V(6); PG8_BAR;
    for (;;) {
        const bool has_next = S.next(ui + 1, nxt);
        const char* nA = has_next ? (const char*)g.A + (size_t)nxt.pm * tstepA + (size_t)nxt.pn * dstep + (size_t)nxt.kt0 * kstep : cA; const char* nB = has_next ? (const char*)g.Bt + (size_t)nxt.pn * tstepB + (size_t)nxt.kt0 * kstep : cB;
        const int nt = cur.nkt;
        for (int t = 0; t < nt; t += 2) {
            const bool last = (t == nt - 2);
            const char* a1 = cA + (size_t)(t + 1) * kstep;
            const char* a2 = last ? nA : cA + (size_t)(t + 2) * kstep; const char* b2 = last ? nB : cB + (size_t)(t + 2) * kstep;
            const char* a3 = a2 + kstep; const char* b3 = b2 + kstep;
            PG8_LDB(B0, 0, 0); PG8_LDB(B1, 0, 1); PG8_SCHED; PG8_LDA(At, 0, 0); PG8_STAGE(PG8_SA(1, 1), a1 + hstepA, voffA);
            PG8_WAIT_V(8); PG8_WAIT_L(0); PG8_BAR; PG8_MMA(0, 0, At, B0); PG8_MMA(0, 1, At, B1); PG8_BAR; PG8_SCHED;
            PG8_LDA(At, 0, 1); PG8_STAGE(PG8_SB(0, 0), b2, voffB); PG8_STAGE(PG8_SB(0, 1), b2 + hstepB, voffB); PG8_STAGE(PG8_SA(0, 0), a2, voffA);
            PG8_WAIT_V(8); PG8_WAIT_L(0); PG8_BAR; PG8_MMA(1, 0, At, B0); PG8_MMA(1, 1, At, B1); PG8_BAR; PG8_SCHED;
            PG8_LDB(B0, 1, 0); PG8_LDB(B1, 1, 1); PG8_SCHED; PG8_LDA(At, 1, 0); PG8_STAGE(PG8_SA(0, 1), a2 + hstepA, voffA);
            PG8_WAIT_V(8); PG8_WAIT_L(0); PG8_BAR; PG8_MMA(0, 0, At, B0); PG8_MMA(0, 1, At, B1); PG8_BAR; PG8_SCHED;
            PG8_LDA(At, 1, 1); PG8_STAGE(PG8_SB(1, 0), b3, voffB); PG8_STAGE(PG8_SB(1, 1), b3 + hstepB, voffB); PG8_STAGE(PG8_SA(1, 0), a3, voffA);
            PG8_WAIT_V(8); PG8_WAIT_L(0); PG8_BAR; PG8_MMA(1, 0, At, B0); PG8_MMA(1, 1, At, B1); PG8_BAR; PG8_SCHED;
        }
        if (wr == 0) PG8_BAR;
        E(acc, cur, wr, wc, fr, fq);
        if (!has_next) break;
#pragma unroll
        for (int a = 0; a < 2; ++a)
#pragma unroll
            for (int b = 0; b < 2; ++b)
#pragma unroll
                for (int m = 0; m < 4; ++m)
#pragma unroll
                    for (int n = 0; n < 2; ++n) acc[a][b][m][n] = (f32x4){0.f, 0.f, 0.f, 0.f};
        cur = nxt; cA = nA; cB = nB; ++ui;
        if (wr == 1) PG8_BAR;
    }
    PG8_WAIT_V(0);
    PG8_BAR;
#undef PG8_SA
#undef PG8_SB
#undef PG8_STAGE
#undef PG8_LDA
#undef PG8_LDB
#undef PG8_MMA
#undef PG8_WAIT_V
#undef PG8_WAIT_L
#undef PG8_BAR
#undef PG8_SCHED
}
}

__device__ __forceinline__ void tail_reduce(const float* PART, bf16_t* Y) {
    for (int id = blockIdx.x * 512 + threadIdx.x; id < 64 * 8192; id += gridDim.x * 512) {
        const int tile = id >> 13, rem = id & 8191, r = rem >> 5, c8 = (rem & 31) * 8;
        f32x4 s0 = (f32x4){0.f, 0.f, 0.f, 0.f}, s1 = s0;
#pragma unroll
        for (int ks = 0; ks < 4; ++ks) { const float* p = PART + (size_t)(ks * 64 + tile) * 65536 + (size_t)r * 256 + c8; s0 += *(const f32x4*)p; s1 += *(const f32x4*)(p + 4); }
        u32x4 w; w.x = cvt_pk_bf16(s0[0], s0[1]); w.y = cvt_pk_bf16(s0[2], s0[3]); w.z = cvt_pk_bf16(s1[0], s1[1]); w.w = cvt_pk_bf16(s1[2], s1[3]);
        *(u32x4*)(Y + (size_t)(32768 + (tile >> 2) * 256 + r) * 1024 + (tile & 3) * 256 + c8) = w;
    }
}

__device__ __forceinline__ void conv_tile(LAS float* tile, const float* src, int ldsrc, int k0, int c0, bf16_t* dst, int ldd, int n0, int kd0, float scale = 1.0f) {
    const int tid = threadIdx.x;
#pragma unroll
    for (int i = 0; i < 2; ++i) { const int e = tid + i * 512, r = e >> 4, c4 = e & 15;
        const f32x4 v = __builtin_nontemporal_load((const f32x4*)(src + (size_t)(k0 + r) * ldsrc + c0 + c4 * 4));
        tile[r * 65 + c4 * 4 + 0] = v[0]; tile[r * 65 + c4 * 4 + 1] = v[1]; tile[r * 65 + c4 * 4 + 2] = v[2]; tile[r * 65 + c4 * 4 + 3] = v[3]; }
    __syncthreads();
    { const int kg = tid & 7, n = tid >> 3; float f[8];
#pragma unroll
      for (int j = 0; j < 8; ++j) f[j] = tile[(kg * 8 + j) * 65 + n] * scale;
      u32x4 w; w.x = cvt_pk_bf16(f[0], f[1]); w.y = cvt_pk_bf16(f[2], f[3]); w.z = cvt_pk_bf16(f[4], f[5]); w.w = cvt_pk_bf16(f[6], f[7]);
      *(u32x4*)(dst + (size_t)(n0 + n) * ldd + kd0 + kg * 8) = w; }
    __syncthreads();
}

__device__ __forceinline__ void phase_prologue(const Args& a, LAS unsigned char* lds) {
    const int tid = threadIdx.x, bid = blockIdx.x, G = gridDim.x;
    unsigned char* ws = a.ws;
    {
        LAS float* s = (LAS float*)lds;
        LAS float* red = (LAS float*)(lds + 9 * 1024 * 4);
        for (int i = tid; i < 9 * 1024; i += 512) { const int r = i >> 10, k = i & 1023; const float v = (r == 0) ? a.in[4][k] : a.in[3][(r - 1) * 1024 + k]; s[i] = silu_f(v); }
        __syncthreads();
        for (int slab = bid; slab < 256; slab += G) {
            const int l = slab >> 7, n0 = (slab & 127) * 48;
            const float* W = a.in[l ? 22 : 5]; const float* bias = a.in[l ? 23 : 6];
            const int kk = tid / 12, n4 = tid % 12;
            float acc[9][4];
#pragma unroll
            for (int r = 0; r < 9; ++r)
#pragma unroll
                for (int j = 0; j < 4; ++j) acc[r][j] = 0.f;
            if (kk < 42) {
#pragma unroll 5
                for (int i = 0; i < 25; ++i) { const int k = kk + 42 * i;
                    if (k < 1024) { const f32x4 w = __builtin_nontemporal_load((const f32x4*)(W + (size_t)k * 6144 + n0 + n4 * 4));
#pragma unroll
                        for (int r = 0; r < 9; ++r) { const float sv = s[r * 1024 + k];
#pragma unroll
                            for (int j = 0; j < 4; ++j) acc[r][j] += sv * w[j]; } } }
#pragma unroll
                for (int r = 0; r < 9; ++r)
#pragma unroll
                    for (int j = 0; j < 4; ++j) red[(kk * 9 + r) * 48 + n4 * 4 + j] = acc[r][j];
            }
            __syncthreads();
            if (tid < 432) { const int r = tid / 48, n = tid % 48; float t = 0.f;
                for (int k2 = 0; k2 < 42; ++k2) t += red[(k2 * 9 + r) * 48 + n];
                ((float*)(ws + WS_MOD))[(size_t)(l * 9 + r) * 6144 + n0 + n] = t + bias[n0 + n]; }
            __syncthreads();
        }
    }
    for (int i = bid * 512 + tid; i < 64 * 512; i += G * 512) { const int p = i >> 9, j = i & 255; const float om = 1.0f / powf(10000.0f, (float)j * (1.0f / 256.0f)); const float ang = (float)p * om;
        ((float*)(ws + WS_PE))[i] = (i & 256) ? cosf(ang) : sinf(ang); }
    {
        LAS float* tile = (LAS float*)lds;
        constexpr int T0 = 512, T1 = T0 + 256, T2 = T1 + 1408, T3 = T2 + 704, T4 = T3 + 1408, T5 = T4 + 704, T6 = T5 + 64, T7 = T6 + 256;
        for (int t = bid; t < T7; t += G) {
            if (t < T0) { const int kt = t & 15, ntl = t >> 4; conv_tile(tile, a.in[9], 2048, kt * 64, ntl * 64, (bf16_t*)(ws + WS_WIN0), 1024, ntl * 64, kt * 64); }
            else if (t < T1) { const int u = t - T0, kt = u & 15, ntl = u >> 4; conv_tile(tile, a.in[17], 1024, kt * 64, ntl * 64, (bf16_t*)(ws + WS_WOUT0), 1024, ntl * 64, kt * 64); }
            else if (t < T2 || (t >= T3 && t < T4)) { const bool l1 = t >= T3; const int u = t - (l1 ? T3 : T1), kt = u & 15, ntl = u >> 4;
                const int n0 = ntl * 64, pn = n0 >> 8, bj = (n0 & 255) >> 7, j0 = n0 & 127, c0 = bj * DFF + pn * 128 + j0;
                conv_tile(tile, a.in[l1 ? 31 : 20], 2 * DFF, kt * 64, c0, (bf16_t*)(ws + (l1 ? WS_FIN1 : WS_FIN0)), 1024, n0, kt * 64, bj ? -0.69314718056f : -1.44269504089f); }
            else if (t < T3 || (t >= T4 && t < T5)) { const bool l1 = t >= T4; const int u = t - (l1 ? T4 : T2), kt = u % 44, ntl = u / 44;
                conv_tile(tile, a.in[l1 ? 32 : 21], 1024, kt * 64, ntl * 64, (bf16_t*)(ws + (l1 ? WS_FOUT1 : WS_FOUT0)), DFF, ntl * 64, kt * 64); }
            else if (t < T6) { const int u = t - T5, g = u >> 4, kt = u & 3, ntl = (u >> 2) & 3;
                conv_tile(tile, a.in[26] + (size_t)g * 65536, 256, kt * 64, ntl * 64, (bf16_t*)(ws + WS_POOLW), 256, g * 256 + ntl * 64, kt * 64); }
            else { const int u = t - T6, mtx = u >> 4, kt = u & 3, ntl = (u >> 2) & 3;
                const int dir = mtx >> 3, gate = (mtx >> 2) & 1, blk = mtx & 3;
                conv_tile(tile, a.in[gate ? 14 : 12] + (size_t)(dir * 4 + blk) * 65536, 256, kt * 64, ntl * 64, (bf16_t*)(ws + WS_WG) + (size_t)mtx * 65536, 256, ntl * 64, kt * 64, -1.44269504089f); }
        }
    }
}

template <int MODE>
__device__ __forceinline__ void rows_load(const float* xsrc, const bf16_t* Y, const float* PE, int row, int lane, f32x4 (&x)[4], u32x2 (&yw)[4], f32x4 (&pe)[4]) {
#pragma unroll
    for (int i = 0; i < 4; ++i) x[i] = (MODE == 0) ? __builtin_nontemporal_load((const f32x4*)(xsrc + (size_t)row * D + 4 * lane + 256 * i)) : *(const f32x4*)(xsrc + (size_t)row * D + 4 * lane + 256 * i);
    if (MODE == 0 || MODE == 4) { const int t = (row - NCTX) & 4095, pr = t >> 6, pc = t & 63;
#pragma unroll
        for (int i = 0; i < 4; ++i) { const int c = 4 * lane + 256 * i; pe[i] = *(const f32x4*)(PE + (size_t)((i < 2) ? pr : pc) * 512 + (c & 511)); }
    }
    if (MODE != 0) {
#pragma unroll
        for (int i = 0; i < 4; ++i) yw[i] = *(const u32x2*)(Y + (size_t)row * D + 4 * lane + 256 * i);
    }
}
template <int MODE>
__device__ __forceinline__ void rows_process(float* X, bf16_t* H, float* RSTD, int row, int lane, float pes, f32x4 (&x)[4], const u32x2 (&yw)[4], const f32x4 (&pe)[4],
                                             const f32x4 (&gp)[4], const f32x4 (&Gm)[4], const f32x4 (&Sm)[4]) {
    if (MODE == 0 || MODE == 4) {
#pragma unroll
        for (int i = 0; i < 4; ++i) x[i] = x[i] + pe[i] * pes;
    }
    if (MODE != 0) {
        float ss = 0.f; f32x4 y[4];
#pragma unroll
        for (int i = 0; i < 4; ++i) { y[i] = (f32x4){bf_lo(yw[i].x), bf_hi(yw[i].x), bf_lo(yw[i].y), bf_hi(yw[i].y)}; ss += (y[i][0] * y[i][0] + y[i][1] * y[i][1]) + (y[i][2] * y[i][2] + y[i][3] * y[i][3]); }
        ss = wave_sum(ss); const float ry = rsqrtf(ss * (1.0f / 1024.0f) + 1e-6f);
#pragma unroll
        for (int i = 0; i < 4; ++i) x[i] = x[i] + gp[i] * (y[i] * ry);
#pragma unroll
        for (int i = 0; i < 4; ++i) *(f32x4*)(X + (size_t)row * D + 4 * lane + 256 * i) = x[i];
    }
    if (MODE != 3) {
        float ss = 0.f;
#pragma unroll
        for (int i = 0; i < 4; ++i) ss += (x[i][0] * x[i][0] + x[i][1] * x[i][1]) + (x[i][2] * x[i][2] + x[i][3] * x[i][3]);
        ss = wave_sum(ss); const float rx = rsqrtf(ss * (1.0f / 1024.0f) + 1e-6f);
        if (MODE == 2) { if (lane == 0) RSTD[row] = rx; }
        else {
#pragma unroll
            for (int i = 0; i < 4; ++i) { const f32x4 h = (x[i] * rx) * Gm[i] + Sm[i]; u32x2 w; w.x = cvt_pk_bf16(h[0], h[1]); w.y = cvt_pk_bf16(h[2], h[3]);
                *(u32x2*)(H + (size_t)row * D + 4 * lane + 256 * i) = w; }
        }
    }
}
template <int MODE>
__device__ __forceinline__ void phase_rows(const Args& a, const float* modL_res  , int gate_idx, const float* post_g,
                           const float* modL_pre, int sh_idx, int sc_idx, const float* pre_g) {
    const int tid = threadIdx.x, lane = tid & 63, wid = tid >> 6;
    const int gw = blockIdx.x * 8 + wid, nw = gridDim.x * 8;
    float* X = a.out; bf16_t* H = (bf16_t*)(a.ws + WS_H); float* RSTD = (float*)(a.ws + WS_RSTD);
    const bf16_t* Y = (const bf16_t*)(a.ws + WS_Y); const float* PE = (const float*)(a.ws + WS_PE);
    const int rows_per = (TROWS + nw - 1) / nw;
    const int r_lo = gw * rows_per, r_hi = (r_lo + rows_per < TROWS) ? r_lo + rows_per : TROWS;
    int row = r_lo;
    while (row < r_hi) {
        const int cr = (row < NCTX) ? 0 : 1 + ((row - NCTX) >> 12);
        int seg_end = (cr == 0) ? NCTX : NCTX + cr * 4096; if (seg_end > r_hi) seg_end = r_hi;
        const float* xsrc = (MODE == 0 || MODE == 4) ? ((cr == 0) ? a.in[0] : a.in[1] - (size_t)NCTX * D) : (const float*)X;
        const float pes = (cr == 0) ? 0.f : 1.f;
        f32x4 gp[4], Gm[4], Sm[4];
#pragma unroll
        for (int i = 0; i < 4; ++i) { const int c = 4 * lane + 256 * i; gp[i] = (f32x4){0.f, 0.f, 0.f, 0.f}; Gm[i] = gp[i]; Sm[i] = gp[i];
            if (MODE != 0) { gp[i] = *(const f32x4*)(modL_res + (size_t)cr * 6144 + gate_idx * 1024 + c) * *(const f32x4*)(post_g + c); }
            if (MODE == 0 || MODE == 1 || MODE == 4) { Gm[i] = (*(const f32x4*)(modL_pre + (size_t)cr * 6144 + sc_idx * 1024 + c) + 1.0f) * *(const f32x4*)(pre_g + c); Sm[i] = *(const f32x4*)(modL_pre + (size_t)cr * 6144 + sh_idx * 1024 + c); } }
        f32x4 xa[4], xb[4], pa[4], pb[4]; u32x2 ya[4], yb[4];
#pragma unroll
        for (int i = 0; i < 4; ++i) { pa[i] = (f32x4){0.f, 0.f, 0.f, 0.f}; pb[i] = pa[i]; ya[i] = (u32x2){0u, 0u}; yb[i] = ya[i]; }
        rows_load<MODE>(xsrc, Y, PE, row, lane, xa, ya, pa);
        for (; row + 1 < seg_end; row += 2) {
            rows_load<MODE>(xsrc, Y, PE, row + 1, lane, xb, yb, pb);
            rows_process<MODE>(X, H, RSTD, row, lane, pes, xa, ya, pa, gp, Gm, Sm);
            rows_load<MODE>(xsrc, Y, PE, (row + 2 < seg_end) ? row + 2 : row + 1, lane, xa, ya, pa);
            rows_process<MODE>(X, H, RSTD, row + 1, lane, pes, xb, yb, pb, gp, Gm, Sm);
        }
        if (row < seg_end) { rows_process<MODE>(X, H, RSTD, row, lane, pes, xa, ya, pa, gp, Gm, Sm); ++row; }
    }
}

template <bool SRC_IN, bool HAS_Y2>
__device__ __forceinline__ void rows2_load(const float* xsrc, const bf16_t* Y1, const bf16_t* Y2, const float* PE, int row, int lane, f32x4 (&x)[4], u32x2 (&y1)[4], u32x2 (&y2)[4], f32x4 (&pe)[4]) {
#pragma unroll
    for (int i = 0; i < 4; ++i) x[i] = SRC_IN ? __builtin_nontemporal_load((const f32x4*)(xsrc + (size_t)row * D + 4 * lane + 256 * i)) : *(const f32x4*)(xsrc + (size_t)row * D + 4 * lane + 256 * i);
    if (SRC_IN) { const int t = (row - NCTX) & 4095, pr = t >> 6, pc = t & 63;
#pragma unroll
        for (int i = 0; i < 4; ++i) { const int c = 4 * lane + 256 * i; pe[i] = *(const f32x4*)(PE + (size_t)((i < 2) ? pr : pc) * 512 + (c & 511)); }
    }
#pragma unroll
    for (int i = 0; i < 4; ++i) y1[i] = *(const u32x2*)(Y1 + (size_t)row * D + 4 * lane + 256 * i);
    if (HAS_Y2) {
#pragma unroll
        for (int i = 0; i < 4; ++i) y2[i] = __builtin_nontemporal_load((const u32x2*)(Y2 + (size_t)row * D + 4 * lane + 256 * i));
    }
}
__device__ __forceinline__ void rows2_addbranch(f32x4 (&x)[4], const u32x2 (&yw)[4], const f32x4 (&gp)[4]) {
    float ss = 0.f; f32x4 y[4];
#pragma unroll
    for (int i = 0; i < 4; ++i) { y[i] = (f32x4){bf_lo(yw[i].x), bf_hi(yw[i].x), bf_lo(yw[i].y), bf_hi(yw[i].y)}; ss += (y[i][0] * y[i][0] + y[i][1] * y[i][1]) + (y[i][2] * y[i][2] + y[i][3] * y[i][3]); }
    ss = wave_sum(ss); const float ry = rsqrtf(ss * (1.0f / 1024.0f) + 1e-6f);
#pragma unroll
    for (int i = 0; i < 4; ++i) x[i] = x[i] + gp[i] * (y[i] * ry);
}
template <bool SRC_IN, bool HAS_Y2, int OUT>
__device__ __forceinline__ void rows2_process(float* X, bf16_t* H, float* RSTD, int row, int lane, float pes, f32x4 (&x)[4], const u32x2 (&y1)[4], const u32x2 (&y2)[4], const f32x4 (&pe)[4],
                                              const f32x4 (&gp1)[4], const f32x4 (&gp2)[4], const f32x4 (&Gm)[4], const f32x4 (&Sm)[4]) {
    if (SRC_IN) {
#pragma unroll
        for (int i = 0; i < 4; ++i) x[i] = x[i] + pe[i] * pes;
    }
    rows2_addbranch(x, y1, gp1);
    if (HAS_Y2) {
        rows2_addbranch(x, y2, gp2);
#pragma unroll
        for (int i = 0; i < 4; ++i) { if (OUT == 2) __builtin_nontemporal_store(x[i], (f32x4*)(X + (size_t)row * D + 4 * lane + 256 * i)); else *(f32x4*)(X + (size_t)row * D + 4 * lane + 256 * i) = x[i]; }
    }
    if (!HAS_Y2 || OUT == 1) {
        float ss = 0.f;
#pragma unroll
        for (int i = 0; i < 4; ++i) ss += (x[i][0] * x[i][0] + x[i][1] * x[i][1]) + (x[i][2] * x[i][2] + x[i][3] * x[i][3]);
        ss = wave_sum(ss); const float rx = rsqrtf(ss * (1.0f / 1024.0f) + 1e-6f);
        if (HAS_Y2) { if (lane == 0) RSTD[row] = rx; }
        else {
#pragma unroll
            for (int i = 0; i < 4; ++i) { const f32x4 h = (x[i] * rx) * Gm[i] + Sm[i]; u32x2 w; w.x = cvt_pk_bf16(h[0], h[1]); w.y = cvt_pk_bf16(h[2], h[3]);
                *(u32x2*)(H + (size_t)row * D + 4 * lane + 256 * i) = w; }
        }
    }
}
template <bool SRC_IN, bool HAS_Y2, int OUT>
__device__ __forceinline__ void phase_rows2(const Args& a, const float* modL  , const float* post1, const float* post2, const float* pre_g) {
    const int tid = threadIdx.x, lane = tid & 63, wid = tid >> 6;
    const int gw = blockIdx.x * 8 + wid, nw = gridDim.x * 8;
    float* X = a.out; bf16_t* H = (bf16_t*)(a.ws + WS_H); float* RSTD = (float*)(a.ws + WS_RSTD);
    const bf16_t* Y1 = (const bf16_t*)(a.ws + WS_Y1); const bf16_t* Y2 = (const bf16_t*)(a.ws + WS_Y); const float* PE = (const float*)(a.ws + WS_PE);
    const int rows_per = (TROWS + nw - 1) / nw;
    const int r_lo = gw * rows_per, r_hi = (r_lo + rows_per < TROWS) ? r_lo + rows_per : TROWS;
    int row = r_lo;
    while (row < r_hi) {
        const int cr = (row < NCTX) ? 0 : 1 + ((row - NCTX) >> 12);
        int seg_end = (cr == 0) ? NCTX : NCTX + cr * 4096; if (seg_end > r_hi) seg_end = r_hi;
        const float* xsrc = SRC_IN ? ((cr == 0) ? a.in[0] : a.in[1] - (size_t)NCTX * D) : (const float*)X;
        const float pes = (cr == 0) ? 0.f : 1.f;
        f32x4 gp1[4], gp2[4], Gm[4], Sm[4];
#pragma unroll
        for (int i = 0; i < 4; ++i) { const int c = 4 * lane + 256 * i; gp2[i] = (f32x4){0.f, 0.f, 0.f, 0.f}; Gm[i] = gp2[i]; Sm[i] = gp2[i];
            gp1[i] = *(const f32x4*)(modL + (size_t)cr * 6144 + 2 * 1024 + c) * *(const f32x4*)(post1 + c);
            if (HAS_Y2) gp2[i] = *(const f32x4*)(modL + (size_t)cr * 6144 + 5 * 1024 + c) * *(const f32x4*)(post2 + c);
            else { Gm[i] = (*(const f32x4*)(modL + (size_t)cr * 6144 + 4 * 1024 + c) + 1.0f) * *(const f32x4*)(pre_g + c); Sm[i] = *(const f32x4*)(modL + (size_t)cr * 6144 + 3 * 1024 + c); } }
        f32x4 xa[4], xb[4], pa[4], pb[4]; u32x2 y1a[4], y1b[4], y2a[4], y2b[4];
#pragma unroll
        for (int i = 0; i < 4; ++i) { pa[i] = (f32x4){0.f, 0.f, 0.f, 0.f}; pb[i] = pa[i]; y2a[i] = (u32x2){0u, 0u}; y2b[i] = y2a[i]; }
        rows2_load<SRC_IN, HAS_Y2>(xsrc, Y1, Y2, PE, row, lane, xa, y1a, y2a, pa);
        for (; row + 1 < seg_end; row += 2) {
            rows2_load<SRC_IN, HAS_Y2>(xsrc, Y1, Y2, PE, row + 1, lane, xb, y1b, y2b, pb);
            rows2_process<SRC_IN, HAS_Y2, OUT>(X, H, RSTD, row, lane, pes, xa, y1a, y2a, pa, gp1, gp2, Gm, Sm);
            rows2_load<SRC_IN, HAS_Y2>(xsrc, Y1, Y2, PE, (row + 2 < seg_end) ? row + 2 : row + 1, lane, xa, y1a, y2a, pa);
            rows2_process<SRC_IN, HAS_Y2, OUT>(X, H, RSTD, row + 1, lane, pes, xb, y1b, y2b, pb, gp1, gp2, Gm, Sm);
        }
        if (row < seg_end) { rows2_process<SRC_IN, HAS_Y2, OUT>(X, H, RSTD, row, lane, pes, xa, y1a, y2a, pa, gp1, gp2, Gm, Sm); ++row; }
    }
}

constexpr int UROW = 528;
__device__ __forceinline__ void phase_scan(const Args& a, LAS unsigned char* lds) {
    const int tid = threadIdx.x, lane = tid & 63, wid = tid >> 6, q = lane >> 4, cl = lane & 15;
    const int hb = blockIdx.x & 7, cb = hb >> 1;
    const int ewave = (hb & 1) * 128 + wid * 16;
    const int ch = cb * 256 + ewave + cl;
    const bf16_t* REC = (const bf16_t*)(a.ws + WS_REC); const bf16_t* WG = (const bf16_t*)(a.ws + WS_WG);
    float* AGG = (float*)(a.ws + WS_AGG);
    float bA[2], bX[2], c8[2];
#pragma unroll
    for (int d = 0; d < 2; ++d) { bA[d] = -1.44269504089f * a.in[13][d * 1024 + ch]; bX[d] = -1.44269504089f * a.in[15][d * 1024 + ch];
        const float lam = a.in[16][d * 1024 + ch]; c8[d] = -8.0f * log1pf(expf(-lam)) * 1.44269504089f; }
    const int ch8 = tid & 31, rgrp = tid >> 5;
    const int loff = q * 4 * 1024 + ch;
    const int nblk = gridDim.x >> 3;
    for (int ck = blockIdx.x >> 3; ck < NCHUNK; ck += nblk) {
        int cis, nch, seqrow0;
        if (ck < 32) { cis = ck & 1; nch = 2; seqrow0 = (ck >> 1) * 256; }
        else { const int k2 = ck - 32; cis = k2 & 31; nch = 32; seqrow0 = NCTX + (k2 >> 5) * 4096; }
        const int t0 = cis * 128, T = nch * 128, row0 = seqrow0 + t0;
        __syncthreads();
        {
            const bf16_t* rp = REC + (size_t)seqrow0 * 1024 + cb * 256 + ch8 * 8;
            u32x4 wv[11];
            f32x4 cwv[4][2], cbv[2];
#pragma unroll
            for (int h2 = 0; h2 < 2; ++h2) { cbv[h2] = *(const f32x4*)(a.in[11] + cb * 256 + ch8 * 8 + 4 * h2);
#pragma unroll
                for (int k = 0; k < 4; ++k) cwv[k][h2] = *(const f32x4*)(a.in[10] + k * 1024 + cb * 256 + ch8 * 8 + 4 * h2); }
#pragma unroll
            for (int i = 0; i < 11; ++i) { const int tr = t0 + rgrp * 8 - 2 + i; const int trc = tr < 0 ? 0 : (tr >= T ? T - 1 : tr);
                const unsigned msk = (tr < 0 || tr >= T) ? 0u : 0xffffffffu;
                wv[i] = *(const u32x4*)(rp + (size_t)trc * 1024) & msk; }
            float prev[3][8] = {};
#pragma unroll
            for (int i = 0; i < 11; ++i) {
                const u32x4 w0 = wv[i]; float v[8];
                v[0] = bf_lo(w0.x); v[1] = bf_hi(w0.x); v[2] = bf_lo(w0.y); v[3] = bf_hi(w0.y); v[4] = bf_lo(w0.z); v[5] = bf_hi(w0.z); v[6] = bf_lo(w0.w); v[7] = bf_hi(w0.w);
                if (i >= 3) { float u[8];
#pragma unroll
                    for (int j = 0; j < 8; ++j) u[j] = cbv[j >> 2][j & 3] + cwv[0][j >> 2][j & 3] * prev[0][j] + cwv[1][j >> 2][j & 3] * prev[1][j] + cwv[2][j >> 2][j & 3] * prev[2][j] + cwv[3][j >> 2][j & 3] * v[j];
                    u32x4 w; w.x = cvt_pk_bf16(u[0], u[1]); w.y = cvt_pk_bf16(u[2], u[3]); w.z = cvt_pk_bf16(u[4], u[5]); w.w = cvt_pk_bf16(u[6], u[7]);
                    *(LAS u32x4*)(lds + (rgrp * 8 + i - 3) * UROW + ch8 * 16) = w; }
#pragma unroll
                for (int j = 0; j < 8; ++j) { prev[0][j] = prev[1][j]; prev[1][j] = prev[2][j]; prev[2][j] = v[j]; }
            }
        }
        bf16x8 Bf[2][8];
#pragma unroll
        for (int g = 0; g < 2; ++g)
#pragma unroll
            for (int ks = 0; ks < 8; ++ks) Bf[g][ks] = *(const bf16x8*)(WG + ((size_t)((0 * 2 + g) * 4 + cb) * 256 + ewave + cl) * 256 + ks * 32 + q * 8);
        __syncthreads();
#pragma unroll
        for (int dir = 0; dir < 2; ++dir) {
            if (dir == 1) {
#pragma unroll
                for (int g = 0; g < 2; ++g)
#pragma unroll
                    for (int ks = 0; ks < 8; ++ks) Bf[g][ks] = *(const bf16x8*)(WG + ((size_t)((1 * 2 + g) * 4 + cb) * 256 + ewave + cl) * 256 + ks * 32 + q * 8);
            }
            const int p = dir ? 3 - q : q;
            float Atot = 1.f, Btot = 0.f;
            unsigned* const dbase = (unsigned*)(a.ws + (dir ? WS_DBB : WS_DBF)) + (size_t)row0 * 1024;
            f32x4 nA = (f32x4){bA[dir], bA[dir], bA[dir], bA[dir]}, nX = (f32x4){bX[dir], bX[dir], bX[dir], bX[dir]};
            { const int m0 = dir ? 7 : 0;
#pragma unroll
              for (int ks = 0; ks < 8; ++ks) { const bf16x8 Af = *(const LAS bf16x8*)(lds + (16 * m0 + cl) * UROW + (ks * 32 + q * 8) * 2);
                  nA = __builtin_amdgcn_mfma_f32_16x16x32_bf16(Af, Bf[0][ks], nA, 0, 0, 0); nX = __builtin_amdgcn_mfma_f32_16x16x32_bf16(Af, Bf[1][ks], nX, 0, 0, 0); } }
#pragma unroll 1
            for (int mm = 0; mm < 8; ++mm) {
                const int m = dir ? 7 - mm : mm;
                const f32x4 accA = nA, accX = nX;
                { const int mn = (mm < 7) ? (dir ? 6 - mm : mm + 1) : m;
                  nA = (f32x4){bA[dir], bA[dir], bA[dir], bA[dir]}; nX = (f32x4){bX[dir], bX[dir], bX[dir], bX[dir]};
#pragma unroll
                  for (int ks = 0; ks < 8; ++ks) { const bf16x8 Af = *(const LAS bf16x8*)(lds + (16 * mn + cl) * UROW + (ks * 32 + q * 8) * 2);
                      nA = __builtin_amdgcn_mfma_f32_16x16x32_bf16(Af, Bf[0][ks], nA, 0, 0, 0); nX = __builtin_amdgcn_mfma_f32_16x16x32_bf16(Af, Bf[1][ks], nX, 0, 0, 0); } }
                unsigned* const drow = dbase + (size_t)(16 * m) * 1024;
                float aa[4], bb[4];
#pragma unroll
                for (int j = 0; j < 4; ++j) {
                    const float uval = __uint_as_float(((unsigned)*(const LAS unsigned short*)(lds + (16 * m + 4 * q + j) * UROW + (ewave + cl) * 2)) << 16);
                    const float t1 = 1.0f + __builtin_amdgcn_exp2f(accA[j]), t2 = 1.0f + __builtin_amdgcn_exp2f(accX[j]), inv = __builtin_amdgcn_rcpf(t1 * t2);
                    const float av = __builtin_amdgcn_exp2f(c8[dir] * (t2 * inv));
                    const float dv = 1.0f - av, bv = __builtin_amdgcn_sqrtf(fmaxf(dv * (1.0f + av), 0.f)) * ((t1 * inv) * uval);
                    __builtin_nontemporal_store(cvt_pk_bf16(dv, bv), drow + loff + j * 1024);
                    aa[j] = av; bb[j] = bv;
                }
                float Al = 1.f, Bl = 0.f;
#pragma unroll
                for (int jj = 0; jj < 4; ++jj) { const int j = dir ? 3 - jj : jj; Bl = aa[j] * Bl + bb[j]; Al *= aa[j]; }
                const float Ao = xchg16(Al, (q & 1) != 0), Bo = xchg16(Bl, (q & 1) != 0);
                const bool first = !(p & 1);
                const float A1 = first ? Al : Ao, B1 = first ? Bl : Bo, A2 = first ? Ao : Al, B2 = first ? Bo : Bl;
                const float Ap = A1 * A2, Bp = A2 * B1 + B2;
                const float Aq = xchg32(Ap, q >= 2), Bq = xchg32(Bp, q >= 2);
                const bool fp = !(p & 2);
                const float A01 = fp ? Ap : Aq, B01 = fp ? Bp : Bq, A23 = fp ? Aq : Ap, B23 = fp ? Bq : Bp;
                const float At = A01 * A23, Bt = A23 * B01 + B23;
                Btot = At * Btot + Bt; Atot *= At;
            }
            if (q == 0) { float* aA = AGG + (size_t)(dir * NCHUNK + ck) * 1024 + ch; aA[0] = Atot; aA[(size_t)2 * NCHUNK * 1024] = Btot; }
        }
    }
}

__device__ __forceinline__ void phase_apply(const Args& a) {
    const unsigned* DBF = (const unsigned*)(a.ws + WS_DBF); const unsigned* DBB = (const unsigned*)(a.ws + WS_DBB);
    const bf16_t* GACT = (const bf16_t*)(a.ws + WS_GACT); bf16_t* MIX = (bf16_t*)(a.ws + WS_REC); const float* CAR = (const float*)(a.ws + WS_CAR);
    for (int it = blockIdx.x; it < NCHUNK * 2; it += gridDim.x) {
        const int ck = it >> 1, ch = (it & 1) * 512 + threadIdx.x; const size_t o0 = (size_t)ck * 128 * 1024 + ch;
        float hf[128];
        {
            float h = CAR[(size_t)(0 * NCHUNK + ck) * 1024 + ch];
            unsigned w[16], wn[16];
#pragma unroll
            for (int j = 0; j < 16; ++j) { w[j] = __builtin_nontemporal_load(DBF + (o0 + (size_t)j * 1024)); wn[j] = 0u; }
#pragma unroll
            for (int blk = 0; blk < 8; ++blk) {
                if (blk < 7) {
#pragma unroll
                    for (int j = 0; j < 16; ++j) wn[j] = __builtin_nontemporal_load(DBF + (o0 + (size_t)((blk + 1) * 16 + j) * 1024));
                }
#pragma unroll
                for (int j = 0; j < 16; ++j) { h = __builtin_fmaf(-bf_lo(w[j]), h, h) + bf_hi(w[j]); hf[blk * 16 + j] = h; }
#pragma unroll
                for (int j = 0; j < 16; ++j) w[j] = wn[j];
            }
        }
        {
            float h = CAR[(size_t)(1 * NCHUNK + ck) * 1024 + ch];
            unsigned w[16], wn[16]; unsigned short g[16], gn[16];
#pragma unroll
            for (int j = 0; j < 16; ++j) { w[j] = __builtin_nontemporal_load(DBB + (o0 + (size_t)(7 * 16 + j) * 1024)); g[j] = __builtin_nontemporal_load(GACT + (o0 + (size_t)(7 * 16 + j) * 1024)); wn[j] = 0u; gn[j] = 0; }
#pragma unroll
            for (int blk = 7; blk >= 0; --blk) {
                if (blk > 0) {
#pragma unroll
                    for (int j = 0; j < 16; ++j) { wn[j] = __builtin_nontemporal_load(DBB + (o0 + (size_t)((blk - 1) * 16 + j) * 1024)); gn[j] = __builtin_nontemporal_load(GACT + (o0 + (size_t)((blk - 1) * 16 + j) * 1024)); }
                }
#pragma unroll
                for (int j = 15; j >= 0; --j) { h = __builtin_fmaf(-bf_lo(w[j]), h, h) + bf_hi(w[j]);
                    const float mv = (hf[blk * 16 + j] + h) * __uint_as_float(((unsigned)g[j]) << 16);
                    MIX[o0 + (size_t)(blk * 16 + j) * 1024] = (bf16_t)(cvt_pk_bf16(mv, 0.f) & 0xffffu); }
#pragma unroll
                for (int j = 0; j < 16; ++j) { w[j] = wn[j]; g[j] = gn[j]; }
            }
        }
    }
}

__device__ __forceinline__ void phase_carry(const Args& a) {
    const float* AGG = (const float*)(a.ws + WS_AGG); float* CAR = (float*)(a.ws + WS_CAR);
    for (int id = blockIdx.x * 512 + threadIdx.x; id < 24 * 2 * 1024; id += gridDim.x * 512) {
        const int ch = id & 1023, dir = (id >> 10) & 1, s = id >> 11;
        const bool lat = s >= 16; const int nch = lat ? 32 : 2, ck0 = lat ? 32 + (s - 16) * 32 : s * 2;
        float h = lat ? a.in[2][(size_t)((s - 16) * 2 + dir) * 1024 + ch] : 0.f;
        const float* aA = AGG + (size_t)(dir * NCHUNK + ck0) * 1024 + ch; const float* aB = aA + (size_t)2 * NCHUNK * 1024;
        float* cr = CAR + (size_t)(dir * NCHUNK + ck0) * 1024 + ch;
        float A[32], B[32];
#pragma unroll
        for (int k = 0; k < 32; ++k) { const int kk = k < nch ? k : nch - 1; A[k] = aA[(size_t)kk * 1024]; B[k] = aB[(size_t)kk * 1024]; }
        if (dir == 0) {
#pragma unroll
            for (int k = 0; k < 32; ++k) if (k < nch) { cr[(size_t)k * 1024] = h; h = A[k] * h + B[k]; }
        } else {
#pragma unroll
            for (int k = 31; k >= 0; --k) if (k < nch) { cr[(size_t)k * 1024] = h; h = A[k] * h + B[k]; }
        }
        if (!lat) a.out[(size_t)TROWS * 1024 + (size_t)(s * 2 + dir) * 1024 + ch] = h;
    }
}

template <int HALF>
__device__ __forceinline__ void pool_item(const float* X, const float* RSTD, bf16_t* P, int seqrow0, int T, int t0, int c, f32x2 Gm) {
    constexpr int NV = 16 + 2 * HALF;
    f32x2 v[NV];
#pragma unroll
    for (int i = 0; i < NV; ++i) { const int tt = t0 - HALF + i; const int tc = tt < 0 ? 0 : (tt >= T ? T - 1 : tt); const size_t r = (size_t)(seqrow0 + tc);
        const float vm = (tt < 0 || tt >= T) ? 0.f : RSTD[r];
        v[i] = *(const f32x2*)(X + r * D + c) * vm; }
    f32x2 S = (f32x2){0.f, 0.f};
#pragma unroll
    for (int i = 0; i < 2 * HALF; ++i) S += v[i];
#pragma unroll
    for (int j = 0; j < 16; ++j) { const int t = t0 + j; const int lo = (t - HALF) < 0 ? 0 : (t - HALF), hi = (t + HALF) > T ? T : (t + HALF);
        const f32x2 o = Gm * (S * (1.0f / (float)(hi - lo)) - v[j + HALF]);
        *(unsigned*)(P + (size_t)(seqrow0 + t) * D + c) = cvt_pk_bf16(o[0], o[1]);
        if (j < 15) S += v[j + 2 * HALF] - v[j]; }
}
__device__ __forceinline__ void phase_pool(const Args& a) {
    const int tid = threadIdx.x;
    const float* X = a.out; const float* RSTD = (const float*)(a.ws + WS_RSTD); bf16_t* P = (bf16_t*)(a.ws + WS_H);
    const float* MOD1 = (const float*)(a.ws + WS_MOD) + (size_t)9 * 6144;
    const int c = 2 * tid, g = tid >> 7;
    const f32x2 pg = *(const f32x2*)(a.in[24] + c);
    for (int it = blockIdx.x; it < TROWS / 16; it += gridDim.x) {
        const int row0 = it * 16;
        int seqrow0, T, cr;
        if (row0 < NCTX) { seqrow0 = row0 & ~255; T = 256; cr = 0; } else { const int lr = row0 - NCTX; seqrow0 = NCTX + (lr & ~4095); T = 4096; cr = 1 + (lr >> 12); }
        const f32x2 Gm = (*(const f32x2*)(MOD1 + (size_t)cr * 6144 + 1 * 1024 + c) + 1.0f) * pg;
        const int t0 = row0 - seqrow0;
        if (g == 0) pool_item<1>(X, RSTD, P, seqrow0, T, t0, c, Gm);
        else if (g == 1) pool_item<2>(X, RSTD, P, seqrow0, T, t0, c, Gm);
        else if (g == 2) pool_item<4>(X, RSTD, P, seqrow0, T, t0, c, Gm);
        else pool_item<8>(X, RSTD, P, seqrow0, T, t0, c, Gm);
    }
}

constexpr int XNROW = 260;
__device__ __forceinline__ void phase_poolmm(const Args& a, LAS unsigned char* lds) {
    const int tid = threadIdx.x, lane = tid & 63, wid = tid >> 6, q = lane >> 4, cl = lane & 15;
    const int g = blockIdx.x & 3, h = 1 << g;
    const float* X = a.out; const float* RSTD = (const float*)(a.ws + WS_RSTD); bf16_t* Y1 = (bf16_t*)(a.ws + WS_Y1);
    const float* MOD1 = (const float*)(a.ws + WS_MOD) + (size_t)9 * 6144;
    const bf16_t* WP = (const bf16_t*)(a.ws + WS_POOLW);
    LAS float* xnl = (LAS float*)lds;
    LAS unsigned char* pl = lds + 80 * XNROW * 4;
    bf16x8 Bf[2][8];
#pragma unroll
    for (int nt = 0; nt < 2; ++nt)
#pragma unroll
        for (int ks = 0; ks < 8; ++ks) Bf[nt][ks] = *(const bf16x8*)(WP + ((size_t)(g * 256 + wid * 32 + nt * 16 + cl)) * 256 + ks * 32 + q * 8);
    float pb[2], ps[2];
#pragma unroll
    for (int nt = 0; nt < 2; ++nt) { const int chn = g * 256 + wid * 32 + nt * 16 + cl; pb[nt] = a.in[27][chn]; ps[nt] = a.in[28][chn]; }
    const int c2 = tid & 127, tq = tid >> 7;
    const f32x2 pg = *(const f32x2*)(a.in[24] + g * 256 + 2 * c2);
    const int srow = tid >> 6, sc4 = tid & 63;
    const int nblk = gridDim.x >> 2;
    f32x4 xv[10]; float vmv[10];
#define PM_ISSUE(ttx) do { const int r0_ = (ttx) * 64; int s0_, s1_; if (r0_ < NCTX) { s0_ = r0_ & ~255; s1_ = s0_ + 256; } else { const int lr_ = r0_ - NCTX; s0_ = NCTX + (lr_ & ~4095); s1_ = s0_ + 4096; } \
        _Pragma("unroll") for (int i = 0; i < 10; ++i) { const int r = r0_ - 8 + srow + 8 * i; const int rc = r < s0_ ? s0_ : (r >= s1_ ? s1_ - 1 : r); \
            vmv[i] = (r < s0_ || r >= s1_) ? 0.f : RSTD[rc]; xv[i] = *(const f32x4*)(X + (size_t)rc * D + g * 256 + sc4 * 4); } } while (0)
    int tt = blockIdx.x >> 2;
    if (tt < TROWS / 64) PM_ISSUE(tt);
    for (; tt < TROWS / 64; tt += nblk) {
        const int r0 = tt * 64; int s0, s1, cr;
        if (r0 < NCTX) { s0 = r0 & ~255; s1 = s0 + 256; cr = 0; } else { const int lr = r0 - NCTX; s0 = NCTX + (lr & ~4095); s1 = s0 + 4096; cr = 1 + (lr >> 12); }
        __syncthreads();
#pragma unroll
        for (int i = 0; i < 10; ++i) *(LAS f32x4*)(xnl + (srow + 8 * i) * XNROW + sc4 * 4) = xv[i] * vmv[i];
        __syncthreads();
        {
            const f32x2 Gm = (*(const f32x2*)(MOD1 + (size_t)cr * 6144 + 1 * 1024 + g * 256 + 2 * c2) + 1.0f) * pg;
            const int tl0 = tq * 16;
            f32x2 S = (f32x2){0.f, 0.f};
            for (int d = -h; d < h; ++d) S += *(const LAS f32x2*)(xnl + (tl0 + 8 + d) * XNROW + 2 * c2);
#pragma unroll 4
            for (int j = 0; j < 16; ++j) { const int tl = tl0 + j, t = r0 + tl; const int lo = (t - h) < s0 ? s0 : (t - h), hi = (t + h) > s1 ? s1 : (t + h);
                const f32x2 xc = *(const LAS f32x2*)(xnl + (tl + 8) * XNROW + 2 * c2);
                const f32x2 o = Gm * (S * (1.0f / (float)(hi - lo)) - xc);
                *(LAS unsigned*)(pl + tl * UROW + c2 * 4) = cvt_pk_bf16(o[0], o[1]);
                S += *(const LAS f32x2*)(xnl + (tl + 8 + h) * XNROW + 2 * c2) - *(const LAS f32x2*)(xnl + (tl + 8 - h) * XNROW + 2 * c2); }
        }
        { const int ttn = (tt + nblk < TROWS / 64) ? tt + nblk : tt; PM_ISSUE(ttn); }
        __syncthreads();
#pragma unroll 1
        for (int m = 0; m < 4; ++m) {
            f32x4 acc[2] = {(f32x4){0.f, 0.f, 0.f, 0.f}, (f32x4){0.f, 0.f, 0.f, 0.f}};
#pragma unroll
            for (int ks = 0; ks < 8; ++ks) { const bf16x8 Af = *(const LAS bf16x8*)(pl + (16 * m + cl) * UROW + (ks * 32 + q * 8) * 2);
                acc[0] = __builtin_amdgcn_mfma_f32_16x16x32_bf16(Af, Bf[0][ks], acc[0], 0, 0, 0); acc[1] = __builtin_amdgcn_mfma_f32_16x16x32_bf16(Af, Bf[1][ks], acc[1], 0, 0, 0); }
            bf16_t* const yrow = Y1 + (size_t)(r0 + 16 * m) * 1024;
#pragma unroll
            for (int nt = 0; nt < 2; ++nt)
#pragma unroll
                for (int j = 0; j < 4; ++j) yrow[(4 * q + j) * 1024 + g * 256 + wid * 32 + nt * 16 + cl] = (bf16_t)(cvt_pk_bf16((acc[nt][j] + pb[nt]) * ps[nt], 0.f) & 0xffffu);
        }
    }
#undef PM_ISSUE
}

__global__ void __launch_bounds__(512, 2) mk_fwd(Args a) {
    extern __shared__ __attribute__((aligned(16))) unsigned char lds_raw[];
    LAS unsigned char* lds = (LAS unsigned char*)lds_raw;
    unsigned char* ws = a.ws;
    const float* MOD0 = (const float*)(ws + WS_MOD); const float* MOD1 = MOD0 + (size_t)9 * 6144;
    bf16_t* Hb = (bf16_t*)(ws + WS_H); bf16_t* Yb = (bf16_t*)(ws + WS_Y); bf16_t* Bb = (bf16_t*)(ws + WS_B);
    const int lo = a.ph_lo, hi = a.ph_hi;
    volatile LAS unsigned* bst = (volatile LAS unsigned*)(lds + LDS_BYTES - 16);
    if (threadIdx.x < 4) bst[threadIdx.x] = 0u;
    __syncthreads();
    XcdBarrier bar; bar.bar = (unsigned*)(ws + WS_BAR); bar.x = 0; bar.st = bst;
    if (hi - lo > 1) bar = xcd_barrier_post((unsigned*)(ws + WS_BAR), bst);
    if (hi > NPH) cg::this_grid().sync();
#define GRID_BAR() xcd_barrier(bar)
#define IN(k) ((PH_MASK & (1 << (k))) && lo <= (k) && (k) < hi)
#define SEAM(k) do { if (lo <= (k) && (k) + 1 < hi) GRID_BAR(); } while (0)
#define REPS(k) (((REP_MASK) >> (k)) & 1 ? 2 : 1)
#define RUN_GEMM(k, tl) do { for (int rep_ = 0; rep_ < REPS(k); ++rep_) { pg8::StaticOrder S; S.init(g.M, g.N, g.K, (int)gridDim.x, (int)blockIdx.x, tl); pg8::gemm_phase(lds, g, S, E); if (rep_ + 1 < REPS(k)) GRID_BAR(); } } while (0)
#define RUN(k, call) do { if (IN(k)) for (int rep_ = 0; rep_ < REPS(k); ++rep_) { call; if (rep_ + 1 < REPS(k)) GRID_BAR(); } SEAM(k); } while (0)
    float* const PARTp = (float*)(ws + WS_H);
    RUN(0, phase_prologue(a, lds));
    RUN(1, phase_rows<0>(a, nullptr, 0, nullptr, MOD0, 0, 1, a.in[7]));
    if (IN(2)) { pg8::Gemm g{Hb, (const bf16_t*)(ws + WS_WIN0), TROWS, 2048, 1024, 1024, 0}; pg8::Epi E{0, (bf16_t*)(ws + WS_GACT), (bf16_t*)(ws + WS_REC), nullptr, nullptr, nullptr, 16}; RUN_GEMM(2, 0); }
    SEAM(2);
    RUN(3, phase_scan(a, lds));
    RUN(4, phase_carry(a));
    RUN(5, phase_apply(a));
    if (IN(6)) { pg8::Gemm g{(const bf16_t*)(ws + WS_REC), (const bf16_t*)(ws + WS_WOUT0), TROWS, 1024, 1024, 1024, 0}; pg8::Epi E{1, (bf16_t*)(ws + WS_Y1), nullptr, nullptr, nullptr, nullptr, 16}; RUN_GEMM(6, 0); }
    SEAM(6);
    if (IN(7)) phase_rows2<true, false, 0>(a, MOD0, a.in[8], nullptr, a.in[18]);
    SEAM(7);
    if (IN(8)) { pg8::Gemm g{Hb, (const bf16_t*)(ws + WS_FIN0), TROWS, 2 * DFF, 1024, 1024, 0}; pg8::Epi E{2, Bb, nullptr, nullptr, nullptr, nullptr, 16}; RUN_GEMM(8, 0); }
    SEAM(8);
    if (IN(9)) { pg8::Gemm g{Bb, (const bf16_t*)(ws + WS_FOUT0), TROWS, 1024, DFF, DFF, 0}; pg8::Epi E{1, Yb, nullptr, nullptr, nullptr, PARTp, 44}; RUN_GEMM(9, 3); }
    SEAM(9);
    if (IN(10)) tail_reduce(PARTp, Yb);
    SEAM(10);
    if (IN(11)) phase_rows2<true, true, 1>(a, MOD0, a.in[8], a.in[19], nullptr);
    SEAM(11);
    RUN(12, phase_poolmm(a, lds));
    if (IN(14)) phase_rows2<false, false, 0>(a, MOD1, a.in[25], nullptr, a.in[29]);
    SEAM(14);
    if (IN(15)) { pg8::Gemm g{Hb, (const bf16_t*)(ws + WS_FIN1), TROWS, 2 * DFF, 1024, 1024, 0}; pg8::Epi E{2, Bb, nullptr, nullptr, nullptr, nullptr, 16}; RUN_GEMM(15, 0); }
    SEAM(15);
    if (IN(16)) { pg8::Gemm g{Bb, (const bf16_t*)(ws + WS_FOUT1), TROWS, 1024, DFF, DFF, 0}; pg8::Epi E{1, Yb, nullptr, nullptr, nullptr, PARTp, 44}; RUN_GEMM(16, 3); }
    SEAM(16);
    if (IN(17)) tail_reduce(PARTp, Yb);
    SEAM(17);
    if (IN(18)) phase_rows2<false, true, 2>(a, MOD1, a.in[25], a.in[30], nullptr);
#undef RUN
#undef GRID_BAR
#undef IN
#undef SEAM
#undef RUN_GEMM
#undef REPS
}

extern "C" void kernel_launch(void* const* d_in, const int* in_sizes, int n_in, void* d_out, int out_size, void* d_ws, size_t ws_size, hipStream_t stream) {
    static int grid = 0;
    if (grid == 0) {
        if (n_in != 33 || ws_size < WS_END) { fprintf(stderr, "kernel_launch: need 33 inputs and %zu bytes of workspace; got %d, %zu\n", (size_t)WS_END, n_in, ws_size); grid = -1; return; }
        int dev = 0, cus = 0, per_cu = 0;
        hipGetDevice(&dev); hipDeviceGetAttribute(&cus, hipDeviceAttributeMultiprocessorCount, dev);
        if (hipFuncSetAttribute((const void*)mk_fwd, hipFuncAttributeMaxDynamicSharedMemorySize, LDS_BYTES) != hipSuccess) { fprintf(stderr, "kernel_launch: hipFuncSetAttribute failed\n"); grid = -1; return; }
        if (hipOccupancyMaxActiveBlocksPerMultiprocessor(&per_cu, (const void*)mk_fwd, 512, LDS_BYTES) != hipSuccess || per_cu < 1) { fprintf(stderr, "kernel_launch: occupancy query says %d\n", per_cu); per_cu = 1; }
        (void)hipGetLastError();
        grid = cus;
    }
    if (grid < 0) return;
    if (hipMemsetAsync((char*)d_ws + WS_BAR, 0, WS_BAR_BYTES, stream) != hipSuccess) { fprintf(stderr, "kernel_launch: memset of the barrier words failed\n"); return; }
    Args a{};
    for (int i = 0; i < 33; ++i) a.in[i] = (const float*)d_in[i];
    a.out = (float*)d_out; a.ws = (unsigned char*)d_ws;
#if MK_PER_PHASE
    for (int ph = 0; ph < NPH; ++ph) { a.ph_lo = ph; a.ph_hi = ph + 1; hipLaunchKernelGGL(mk_fwd, dim3(grid), dim3(512), LDS_BYTES, stream, a); }
#else
    a.ph_lo = 0; a.ph_hi = NPH;
    void* args[] = {&a};
    hipError_t e = hipLaunchCooperativeKernel((const void*)mk_fwd, dim3(grid), dim3(512), args, LDS_BYTES, stream);
    if (e != hipSuccess) fprintf(stderr, "cooperative launch failed: %s (grid %d)\n", hipGetErrorString(e), grid);
#endif
}
```

```cpp
#include <hip/hip_runtime.h>
#include <hip/hip_cooperative_groups.h>
#include <cstdio>
namespace cg = cooperative_groups;

#ifndef PH_MASK
#define PH_MASK 0x7FFFF
#endif
#ifndef REP_MASK
#define REP_MASK 0x0
#endif
#ifndef MK_PER_PHASE
#define MK_PER_PHASE 0
#endif

#define LAS __attribute__((address_space(3)))
typedef unsigned short bf16_t;
typedef short bf16x8 __attribute__((ext_vector_type(8)));
typedef float f32x4 __attribute__((ext_vector_type(4)));
typedef float f32x2 __attribute__((ext_vector_type(2)));
typedef unsigned u32x4 __attribute__((ext_vector_type(4)));
typedef unsigned u32x2 __attribute__((ext_vector_type(2)));

constexpr int D = 1024, DFF = 2816, NCTX = 16 * 256, NLAT = 8 * 4096, TROWS = NCTX + NLAT;
constexpr int NCHUNK = TROWS / 128;
constexpr int LDS_BYTES = 135168 + 16;
constexpr int NPH = 19;

constexpr size_t al256(size_t x) { return (x + 255) & ~(size_t)255; }
constexpr size_t WS_BAR = 0;
constexpr size_t WS_BAR_BYTES = 3456 * 4;
constexpr size_t WS_MOD = al256(WS_BAR + WS_BAR_BYTES);
constexpr size_t WS_PE = al256(WS_MOD + 2 * 9 * 6144 * 4);
constexpr size_t WS_RSTD = al256(WS_PE + 64 * 512 * 4);
constexpr size_t WS_AGG = al256(WS_RSTD + (size_t)TROWS * 4);
constexpr size_t WS_CAR = al256(WS_AGG + (size_t)2 * 2 * NCHUNK * 1024 * 4);
constexpr size_t WS_WIN0 = al256(WS_CAR + (size_t)2 * NCHUNK * 1024 * 4);
constexpr size_t WS_WOUT0 = WS_WIN0 + (size_t)2048 * 1024 * 2;
constexpr size_t WS_FIN0 = WS_WOUT0 + (size_t)1024 * 1024 * 2;
constexpr size_t WS_FOUT0 = WS_FIN0 + (size_t)5632 * 1024 * 2;
constexpr size_t WS_FIN1 = WS_FOUT0 + (size_t)1024 * 2816 * 2;
constexpr size_t WS_FOUT1 = WS_FIN1 + (size_t)5632 * 1024 * 2;
constexpr size_t WS_POOLW = WS_FOUT1 + (size_t)1024 * 2816 * 2;
constexpr size_t WS_WG = WS_POOLW + (size_t)1024 * 256 * 2;
constexpr size_t MIB = 1024 * 1024;
constexpr size_t WS_BASE = al256(WS_WG + (size_t)16 * 256 * 256 * 2);
constexpr size_t WS_H = WS_BASE;
constexpr size_t WS_Y = WS_BASE + 72 * MIB;
constexpr size_t WS_Y1 = WS_BASE + 144 * MIB;
constexpr size_t WS_B = WS_BASE + 216 * MIB;
constexpr size_t WS_DBF = WS_BASE;
constexpr size_t WS_DBB = WS_BASE + 144 * MIB;
constexpr size_t WS_GACT = WS_BASE + 288 * MIB;
constexpr size_t WS_REC = WS_BASE + 360 * MIB;
constexpr size_t WS_END = WS_BASE + 432 * MIB;

struct Args { const float* in[33]; float* out; unsigned char* ws; int ph_lo, ph_hi; };

__device__ __forceinline__ unsigned cvt_pk_bf16(float lo, float hi) { unsigned r; asm volatile("v_cvt_pk_bf16_f32 %0, %1, %2" : "=v"(r) : "v"(lo), "v"(hi)); return r; }
__device__ __forceinline__ float bf_lo(unsigned w) { return __uint_as_float(w << 16); }
__device__ __forceinline__ float bf_hi(unsigned w) { return __uint_as_float(w & 0xffff0000u); }
__device__ __forceinline__ float sigmoid_f(float x) { return __builtin_amdgcn_rcpf(1.0f + __builtin_amdgcn_exp2f(-1.44269504089f * x)); }
__device__ __forceinline__ float silu_f(float x) { return x * sigmoid_f(x); }
__device__ __forceinline__ float gelu_tanh_f(float x) { const float z = x + 0.044715f * x * x * x; return x * __builtin_amdgcn_rcpf(1.0f + __builtin_amdgcn_exp2f(-2.0f * 0.7978845608f * 1.44269504089f * z)); }
__device__ __forceinline__ float xchg16(float x, bool oddrow) { const u32x2 r = __builtin_amdgcn_permlane16_swap(__float_as_uint(x), __float_as_uint(x), false, false); return __uint_as_float(oddrow ? r.x : r.y); }
__device__ __forceinline__ float xchg32(float x, bool upper) { const u32x2 r = __builtin_amdgcn_permlane32_swap(__float_as_uint(x), __float_as_uint(x), false, false); return __uint_as_float(upper ? r.x : r.y); }
__device__ __forceinline__ float wave_sum(float v) {
#pragma unroll
    for (int o = 32; o >= 1; o >>= 1) v += __shfl_xor(v, o);
    return v;
}

#define XB_TMO      128
#define XB_XCNT(j)  (256  + 64 * (j))
#define XB_XSUB(j)  (1280 + 64 * (j))
#define XB_XGEN(j)  (2304 + 64 * (j))
#define XB_TOP      3328
#define XB_TOPGEN   3392
#define XCD_BAR_WORDS 3456
#define XB_SPIN_CAP (1u << 22)
__device__ __forceinline__ unsigned xb_ld(unsigned* p)              { return __hip_atomic_load(p, __ATOMIC_RELAXED, __HIP_MEMORY_SCOPE_AGENT); }
__device__ __forceinline__ unsigned xb_add(unsigned* p, unsigned v) { return __hip_atomic_fetch_add(p, v, __ATOMIC_RELAXED, __HIP_MEMORY_SCOPE_AGENT); }
__device__ __forceinline__ unsigned xb_xcc_id() { return (unsigned)__builtin_amdgcn_s_getreg((3 << 11) | 20) & 0xFu; }
#define XB_SPIN(cond, bar) do { unsigned _sp = 0; while (cond) { __builtin_amdgcn_s_sleep(1); \
    if ((++_sp & 255u) == 0u) { if (xb_ld(&(bar)[XB_TMO])) break; if (_sp > XB_SPIN_CAP) { atomicAdd(&(bar)[XB_TMO], 1u); break; } } } } while (0)
struct XcdBarrier { unsigned* bar; unsigned x; volatile LAS unsigned* st; };
__device__ __forceinline__ XcdBarrier xcd_barrier_post(unsigned* bar, volatile LAS unsigned* st) {
    XcdBarrier b; b.bar = bar; b.x = xb_xcc_id(); b.st = st;
    if (threadIdx.x == 0) (void)xb_add(&bar[XB_XCNT(b.x)], 1u);
    return b;
}
__device__ __forceinline__ void xcd_barrier_complete(unsigned* bar, unsigned x, unsigned& nloc, unsigned& nx) {
    const unsigned G = gridDim.x * gridDim.y * gridDim.z;
    unsigned sum, cnt, mine, sp = 0u;
    for (;;) {
        sum = 0u; cnt = 0u; mine = 0u;
#pragma unroll
        for (unsigned j = 0; j < 16; ++j) { const unsigned c = xb_ld(&bar[XB_XCNT(j)]); sum += c; cnt += (c > 0u) ? 1u : 0u; mine = (j == x) ? c : mine; }
        if (sum == G) break;
        __builtin_amdgcn_s_sleep(1);
        if ((++sp & 255u) == 0u) { if (xb_ld(&bar[XB_TMO])) break; if (sp > XB_SPIN_CAP) { atomicAdd(&bar[XB_TMO], 1u); break; } }
    }
    nloc = mine > 0u ? mine : 1u; nx = cnt > 0u ? cnt : 1u;
}
__device__ __forceinline__ void xcd_barrier(const XcdBarrier& b) {
    asm volatile("s_waitcnt vmcnt(0)" ::: "memory");
    __syncthreads();
    if (threadIdx.x == 0) {
        unsigned* bar = b.bar;
        __builtin_amdgcn_s_waitcnt(0);
        unsigned nloc = b.st[0], nx = b.st[1];
        if (nloc == 0u) { xcd_barrier_complete(bar, b.x, nloc, nx); b.st[0] = nloc; b.st[1] = nx; }
        const unsigned old = xb_add(&bar[XB_XSUB(b.x)], 1u);
        const unsigned gen = old / nloc;
        if (old + 1u == (gen + 1u) * nloc) {
            __builtin_amdgcn_fence(__ATOMIC_RELEASE, "agent");
            asm volatile("s_waitcnt vmcnt(0)" ::: "memory");
            const unsigned og = xb_add(&bar[XB_TOP], 1u);
            const unsigned tg = og / nx;
            if (og + 1u == (tg + 1u) * nx) xb_add(&bar[XB_TOPGEN], 1u);
            else XB_SPIN(xb_ld(&bar[XB_TOPGEN]) == tg, bar);
            __builtin_amdgcn_fence(__ATOMIC_ACQUIRE, "agent");
            xb_add(&bar[XB_XGEN(b.x)], 1u);
            asm volatile("s_waitcnt vmcnt(0)" ::: "memory");
        } else {
            XB_SPIN(xb_ld(&bar[XB_XGEN(b.x)]) == gen, bar);
            __builtin_amdgcn_fence(__ATOMIC_ACQUIRE, "agent");
            asm volatile("s_waitcnt vmcnt(0)" ::: "memory");
        }
    }
    __syncthreads();
}

namespace pg8 {
constexpr int BM = 256, BK = 64, HALF = 128, HTB = HALF * BK * 2, STAGE_BYTES = 8 * HTB, NXCD = 8, WGM = 8;
__host__ __device__ __forceinline__ int lds_byte(int r, int c) { const int st = (r >> 4) * 2 + (c >> 5), rr = r & 15, cc = c & 31, ob = rr * 64 + cc * 2; return st * 1024 + (ob ^ (((ob >> 9) & 1) << 5)); }
__host__ __device__ __forceinline__ void stage_rc(int b, int& R, int& C) { const int st = b / 1024, sb = b % 1024, swz = sb ^ (((sb >> 9) & 1) << 5); R = (st >> 1) * 16 + swz / 64; C = (st & 1) * 32 + (swz % 64) / 2; }
__host__ __device__ __forceinline__ int perm32(int rho) { const int n = rho >> 4, i = rho & 15; return 8 * (i >> 2) + 4 * n + (i & 3); }
struct Unit { int pm, pn, kt0, nkt; };
struct Gemm { const bf16_t* A; const bf16_t* Bt; int M, N, K, lda, diag; };
struct StaticOrder {
    int nM, nN, nwg, G, c, ntfull, tail, rev;
    __device__ __forceinline__ void init(int M, int N, int K, int G_, int c_, int tail_) { nM = M / BM; nN = N / BM; G = G_; c = c_; ntfull = K / BK; rev = tail_ >> 1; tail_ &= 1; tail = (tail_ && G_ == 256 && nM == 144 && nN == 4 && ntfull == 44) ? 1 : 0; if (tail) nM = 128; nwg = nM * nN; }
    __device__ __forceinline__ bool next(int i, Unit& u) const {
        if (tail && i == 2) { const int tile = c >> 2, ks = c & 3; u.pm = 128 + (tile >> 2); u.pn = tile & 3; u.kt0 = ks < 2 ? ks * 12 : 24 + (ks - 2) * 10; u.nkt = ks < 2 ? 12 : 10; return true; }
        long L = (long)i * G + c; if (L >= nwg) return false; if (rev) L = nwg - 1 - L;
        int wgid = (int)L; { const int q = nwg / NXCD, r = nwg % NXCD, xcd = wgid % NXCD, off = wgid / NXCD; wgid = (xcd < r ? xcd * (q + 1) : r * (q + 1) + (xcd - r) * q) + off; }
        const int nig = WGM * nN, gid = wgid / nig, fm = gid * WGM, gsz = (nM - fm) < WGM ? (nM - fm) : WGM;
        u.pm = fm + ((wgid % nig) % gsz); u.pn = (wgid % nig) / gsz; u.kt0 = 0; u.nkt = ntfull; return true;
    }
};
struct Epi {
    int mode;
    bf16_t* O0; bf16_t* O1; const float* pb; const float* ps; float* PART; int ntfull;
    __device__ __forceinline__ void operator()(const f32x4 (&acc)[2][2][4][2], const Unit& u, int wr, int wc, int fr, int fq) const {
        const int row0 = u.pm * BM + wr * 64 + fr;
        if (u.nkt != ntfull) {
            const int ks = u.kt0 == 0 ? 0 : (u.kt0 == 12 ? 1 : (u.kt0 == 24 ? 2 : 3)), tile = (u.pm - 128) * 4 + u.pn;
            bf16_t* dst = (bf16_t*)PART + (size_t)(ks * 64 + tile) * 65536 + (size_t)(wr * 64 + fr) * 256 + wc * 32 + 8 * fq;
#pragma unroll
            for (int ai = 0; ai < 2; ++ai)
#pragma unroll
                for (int m = 0; m < 4; ++m)
#pragma unroll
                    for (int bj = 0; bj < 2; ++bj) { const f32x4 v0 = acc[ai][bj][m][0], v1 = acc[ai][bj][m][1];
                        u32x4 w; w.x = cvt_pk_bf16(v0[0], v0[1]); w.y = cvt_pk_bf16(v0[2], v0[3]); w.z = cvt_pk_bf16(v1[0], v1[1]); w.w = cvt_pk_bf16(v1[2], v1[3]);
                        *(u32x4*)(dst + (size_t)(ai * HALF + m * 16) * 256 + bj * HALF) = w; }
            return;
        }
        if (mode == 2) {
            const int col0 = u.pn * 128 + wc * 32 + 8 * fq;
#pragma unroll
            for (int ai = 0; ai < 2; ++ai)
#pragma unroll
                for (int m = 0; m < 4; ++m) {
                    bf16_t* rowp = O0 + (size_t)(row0 + ai * HALF + m * 16) * DFF + col0;
                    const f32x4 g0 = acc[ai][0][m][0], g1 = acc[ai][0][m][1], u0 = acc[ai][1][m][0], u1 = acc[ai][1][m][1];
                    u32x4 w;
#define SWG(gv, uv) (((gv) * (uv)) * __builtin_amdgcn_rcpf(1.0f + __builtin_amdgcn_exp2f(gv)))
                    w.x = cvt_pk_bf16(SWG(g0[0], u0[0]), SWG(g0[1], u0[1])); w.y = cvt_pk_bf16(SWG(g0[2], u0[2]), SWG(g0[3], u0[3]));
                    w.z = cvt_pk_bf16(SWG(g1[0], u1[0]), SWG(g1[1], u1[1])); w.w = cvt_pk_bf16(SWG(g1[2], u1[2]), SWG(g1[3], u1[3]));
#undef SWG
                    *(u32x4*)rowp = w;
                }
        } else {
            bf16_t* base = O0; int colt = u.pn * BM; bool act = false;
            if (mode == 0) { if (u.pn >= 4) { base = O1; colt -= 1024; } else act = true; }
            const int col0 = colt + wc * 32 + 8 * fq;
            f32x4 bv[2][2], sv[2][2];
#pragma unroll
            for (int bj = 0; bj < 2; ++bj)
#pragma unroll
                for (int n = 0; n < 2; ++n) {
                    if (mode == 3) { bv[bj][n] = *(const f32x4*)(pb + col0 + bj * HALF + 4 * n); sv[bj][n] = *(const f32x4*)(ps + col0 + bj * HALF + 4 * n); }
                    else { bv[bj][n] = (f32x4){0.f, 0.f, 0.f, 0.f}; sv[bj][n] = (f32x4){1.f, 1.f, 1.f, 1.f}; }
                }
#pragma unroll
            for (int ai = 0; ai < 2; ++ai)
#pragma unroll
                for (int m = 0; m < 4; ++m) {
                    bf16_t* rowp = base + (size_t)(row0 + ai * HALF + m * 16) * D + col0;
#pragma unroll
                    for (int bj = 0; bj < 2; ++bj) {
                        f32x4 v0 = (acc[ai][bj][m][0] + bv[bj][0]) * sv[bj][0], v1 = (acc[ai][bj][m][1] + bv[bj][1]) * sv[bj][1];
                        if (act) {
#pragma unroll
                            for (int j = 0; j < 4; ++j) { v0[j] = gelu_tanh_f(v0[j]); v1[j] = gelu_tanh_f(v1[j]); }
                        }
                        u32x4 w; w.x = cvt_pk_bf16(v0[0], v0[1]); w.y = cvt_pk_bf16(v0[2], v0[3]); w.z = cvt_pk_bf16(v1[0], v1[1]); w.w = cvt_pk_bf16(v1[2], v1[3]);
                        *(u32x4*)(rowp + bj * HALF) = w;
                    }
                }
        }
    }
};

__device__ __forceinline__ void gemm_phase(LAS unsigned char* lds, const Gemm g, const StaticOrder& S, const Epi& E) {
    const int tid = threadIdx.x, wid = __builtin_amdgcn_readfirstlane(tid >> 6), lane = tid & 63, wr = wid >> 2, wc = wid & 3, fr = lane & 15, fq = lane >> 4;
    const int K = g.K, lda = g.lda;
    unsigned voffA[2], voffB[2];
#pragma unroll
    for (int i = 0; i < 2; ++i) { int R, C; stage_rc(tid * 16 + i * 8192, R, C); const int Rb = (R & ~31) + perm32(R & 31);
        voffA[i] = (unsigned)(R * lda + C) * 2u; voffB[i] = (unsigned)(Rb * K + C) * 2u; }
    const size_t kstep = (size_t)(BK * 2);
    const size_t hstepA = (size_t)HALF * lda * 2, hstepB = (size_t)HALF * K * 2;
    const size_t tstepA = 2 * hstepA, tstepB = 2 * hstepB;
    const size_t dstep = g.diag ? (size_t)K * 2 : 0;
    const unsigned ldsw = (unsigned)wid * 1024u;
    const int aoff = lds_byte(wr * 64 + fr, fq * 8), boff = lds_byte(wc * 32 + fr, fq * 8);
#define PG8_SA(b, h) (((b) * 2 + (h)) * HTB)
#define PG8_SB(b, h) ((4 + (b) * 2 + (h)) * HTB)
#define PG8_STAGE(bufoff, gbase, voff) do { _Pragma("unroll") for (int _i = 0; _i < 2; ++_i) \
        __builtin_amdgcn_global_load_lds((const unsigned*)((const char*)(gbase) + (voff)[_i]), (LAS unsigned*)(lds + (bufoff) + ldsw + _i * 8192), 16, 0, 0); } while (0)
#define PG8_LDA(dst, b, h) do { _Pragma("unroll") for (int m = 0; m < 4; ++m) _Pragma("unroll") for (int k = 0; k < 2; ++k) dst[m][k] = *(const LAS bf16x8*)(lds + PG8_SA(b, h) + aoff + m * 2048 + k * 1024); } while (0)
#define PG8_LDB(dst, b, h) do { _Pragma("unroll") for (int n = 0; n < 2; ++n) _Pragma("unroll") for (int k = 0; k < 2; ++k) dst[n][k] = *(const LAS bf16x8*)(lds + PG8_SB(b, h) + boff + n * 2048 + k * 1024); } while (0)
#define PG8_MMA(ai, bj, At, Bt) do { __builtin_amdgcn_s_setprio(1); _Pragma("unroll") for (int m = 0; m < 4; ++m) _Pragma("unroll") for (int n = 0; n < 2; ++n) _Pragma("unroll") for (int k = 0; k < 2; ++k) \
        acc[ai][bj][m][n] = __builtin_amdgcn_mfma_f32_16x16x32_bf16(Bt[n][k], At[m][k], acc[ai][bj][m][n], 0, 0, 0); __builtin_amdgcn_s_setprio(0); } while (0)
#define PG8_WAIT_V(n) asm volatile("s_waitcnt vmcnt(" #n ")" ::: "memory")
#define PG8_WAIT_L(n) asm volatile("s_waitcnt lgkmcnt(" #n ")" ::: "memory")
#define PG8_BAR __builtin_amdgcn_s_barrier()
#define PG8_SCHED __builtin_amdgcn_sched_barrier(0)
    Unit cur, nxt; int ui = 0;
    if (!S.next(0, cur)) return;
    f32x4 acc[2][2][4][2];
#pragma unroll
    for (int a = 0; a < 2; ++a)
#pragma unroll
        for (int b = 0; b < 2; ++b)
#pragma unroll
            for (int m = 0; m < 4; ++m)
#pragma unroll
                for (int n = 0; n < 2; ++n) acc[a][b][m][n] = (f32x4){0.f, 0.f, 0.f, 0.f};
    bf16x8 At[4][2], B0[2][2], B1[2][2];
    const char* cA = (const char*)g.A + (size_t)cur.pm * tstepA + (size_t)cur.pn * dstep + (size_t)cur.kt0 * kstep; const char* cB = (const char*)g.Bt + (size_t)cur.pn * tstepB + (size_t)cur.kt0 * kstep;
    PG8_STAGE(PG8_SB(0, 0), cB, voffB); PG8_STAGE(PG8_SB(0, 1), cB + hstepB, voffB); PG8_STAGE(PG8_SA(0, 0), cA, voffA); PG8_STAGE(PG8_SA(0, 1), cA + hstepA, voffA);
    if (wr == 1) PG8_BAR;
    PG8_WAIT_V(2); PG8_BAR;
    PG8_STAGE(PG8_SB(1, 0), cB + kstep, voffB); PG8_STAGE(PG8_SA(1, 0), cA + kstep, voffA); PG8_STAGE(PG8_SB(1, 1), cB + hstepB + kstep, voffB);
    PG8_WAIT_V(6); PG8_BAR;
    for (;;) {
        const bool has_next = S.next(ui + 1, nxt);
        const char* nA = has_next ? (const char*)g.A + (size_t)nxt.pm * tstepA + (size_t)nxt.pn * dstep + (size_t)nxt.kt0 * kstep : cA; const char* nB = has_next ? (const char*)g.Bt + (size_t)nxt.pn * tstepB + (size_t)nxt.kt0 * kstep : cB;
        const int nt = cur.nkt;
        for (int t = 0; t < nt; t += 2) {
            const bool last = (t == nt - 2);
            const char* a1 = cA + (size_t)(t + 1) * kstep;
            const char* a2 = last ? nA : cA + (size_t)(t + 2) * kstep; const char* b2 = last ? nB : cB + (size_t)(t + 2) * kstep;
            const char* a3 = a2 + kstep; const char* b3 = b2 + kstep;
            PG8_LDB(B0, 0, 0); PG8_LDB(B1, 0, 1); PG8_SCHED; PG8_LDA(At, 0, 0); PG8_STAGE(PG8_SA(1, 1), a1 + hstepA, voffA);
            PG8_WAIT_V(8); PG8_WAIT_L(0); PG8_BAR; PG8_MMA(0, 0, At, B0); PG8_MMA(0, 1, At, B1); PG8_BAR; PG8_SCHED;
            PG8_LDA(At, 0, 1); PG8_STAGE(PG8_SB(0, 0), b2, voffB); PG8_STAGE(PG8_SB(0, 1), b2 + hstepB, voffB); PG8_STAGE(PG8_SA(0, 0), a2, voffA);
            PG8_WAIT_V(8); PG8_WAIT_L(0); PG8_BAR; PG8_MMA(1, 0, At, B0); PG8_MMA(1, 1, At, B1); PG8_BAR; PG8_SCHED;
            PG8_LDB(B0, 1, 0); PG8_LDB(B1, 1, 1); PG8_SCHED; PG8_LDA(At, 1, 0); PG8_STAGE(PG8_SA(0, 1), a2 + hstepA, voffA);
            PG8_WAIT_V(8); PG8_WAIT_L(0); PG8_BAR; PG8_MMA(0, 0, At, B0); PG8_MMA(0, 1, At, B1); PG8_BAR; PG8_SCHED;
            PG8_LDA(At, 1, 1); PG8_STAGE(PG8_SB(1, 0), b3, voffB); PG8_STAGE(PG8_SB(1, 1), b3 + hstepB, voffB); PG8_STAGE(PG8_SA(1, 0), a3, voffA);
            PG8_WAIT_V(8); PG8_WAIT_L(0); PG8_BAR; PG8_MMA(1, 0, At, B0); PG8_MMA(1, 1, At, B1); PG8_BAR; PG8_SCHED;
        }
        if (wr == 0) PG8_BAR;
        E(acc, cur, wr, wc, fr, fq);
        if (!has_next) break;
#pragma unroll
        for (int a = 0; a < 2; ++a)
#pragma unroll
            for (int b = 0; b < 2; ++b)
#pragma unroll
                for (int m = 0; m < 4; ++m)
#pragma unroll
                    for (int n = 0; n < 2; ++n) acc[a][b][m][n] = (f32x4){0.f, 0.f, 0.f, 0.f};
        cur = nxt; cA = nA; cB = nB; ++ui;
        if (wr == 1) PG8_BAR;
    }
    PG8_WAIT_V(0);
    PG8_BAR;
#undef PG8_SA
#undef PG8_SB
#undef PG8_STAGE
#undef PG8_LDA
#undef PG8_LDB
#undef PG8_MMA
#undef PG8_WAIT_V
#undef PG8_WAIT_L
#undef PG8_BAR
#undef PG8_SCHED
}
}

__device__ __forceinline__ void tail_reduce(const float* PART, bf16_t* Y) {
    for (int id = blockIdx.x * 512 + threadIdx.x; id < 64 * 8192; id += gridDim.x * 512) {
        const int tile = id >> 13, rem = id & 8191, r = rem >> 5, c8 = (rem & 31) * 8;
        f32x4 s0 = (f32x4){0.f, 0.f, 0.f, 0.f}, s1 = s0;
#pragma unroll
        for (int ks = 0; ks < 4; ++ks) { const u32x4 p = *(const u32x4*)((const bf16_t*)PART + (size_t)(ks * 64 + tile) * 65536 + (size_t)r * 256 + c8);
            s0 += (f32x4){bf_lo(p.x), bf_hi(p.x), bf_lo(p.y), bf_hi(p.y)}; s1 += (f32x4){bf_lo(p.z), bf_hi(p.z), bf_lo(p.w), bf_hi(p.w)}; }
        u32x4 w; w.x = cvt_pk_bf16(s0[0], s0[1]); w.y = cvt_pk_bf16(s0[2], s0[3]); w.z = cvt_pk_bf16(s1[0], s1[1]); w.w = cvt_pk_bf16(s1[2], s1[3]);
        *(u32x4*)(Y + (size_t)(32768 + (tile >> 2) * 256 + r) * 1024 + (tile & 3) * 256 + c8) = w;
    }
}

__device__ __forceinline__ void conv_tile(LAS float* tile, const float* src, int ldsrc, int k0, int c0, bf16_t* dst, int ldd, int n0, int kd0, float scale = 1.0f) {
    const int tid = threadIdx.x;
#pragma unroll
    for (int i = 0; i < 2; ++i) { const int e = tid + i * 512, r = e >> 4, c4 = e & 15;
        const f32x4 v = __builtin_nontemporal_load((const f32x4*)(src + (size_t)(k0 + r) * ldsrc + c0 + c4 * 4));
        tile[r * 65 + c4 * 4 + 0] = v[0]; tile[r * 65 + c4 * 4 + 1] = v[1]; tile[r * 65 + c4 * 4 + 2] = v[2]; tile[r * 65 + c4 * 4 + 3] = v[3]; }
    __syncthreads();
    { const int kg = tid & 7, n = tid >> 3; float f[8];
#pragma unroll
      for (int j = 0; j < 8; ++j) f[j] = tile[(kg * 8 + j) * 65 + n] * scale;
      u32x4 w; w.x = cvt_pk_bf16(f[0], f[1]); w.y = cvt_pk_bf16(f[2], f[3]); w.z = cvt_pk_bf16(f[4], f[5]); w.w = cvt_pk_bf16(f[6], f[7]);
      *(u32x4*)(dst + (size_t)(n0 + n) * ldd + kd0 + kg * 8) = w; }
    __syncthreads();
}

__device__ __forceinline__ void phase_prologue(const Args& a, LAS unsigned char* lds) {
    const int tid = threadIdx.x, bid = blockIdx.x, G = gridDim.x;
    unsigned char* ws = a.ws;
    {
        LAS float* s = (LAS float*)lds;
        LAS float* red = (LAS float*)(lds + 9 * 1024 * 4);
        for (int i = tid; i < 9 * 1024; i += 512) { const int r = i >> 10, k = i & 1023; const float v = (r == 0) ? a.in[4][k] : a.in[3][(r - 1) * 1024 + k]; s[i] = silu_f(v); }
        __syncthreads();
        for (int slab = bid; slab < 256; slab += G) {
            const int l = slab >> 7, n0 = (slab & 127) * 48;
            const float* W = a.in[l ? 22 : 5]; const float* bias = a.in[l ? 23 : 6];
            const int kk = tid / 12, n4 = tid % 12;
            float acc[9][4];
#pragma unroll
            for (int r = 0; r < 9; ++r)
#pragma unroll
                for (int j = 0; j < 4; ++j) acc[r][j] = 0.f;
            if (kk < 42) {
#pragma unroll 5
                for (int i = 0; i < 25; ++i) { const int k = kk + 42 * i;
                    if (k < 1024) { const f32x4 w = __builtin_nontemporal_load((const f32x4*)(W + (size_t)k * 6144 + n0 + n4 * 4));
#pragma unroll
                        for (int r = 0; r < 9; ++r) { const float sv = s[r * 1024 + k];
#pragma unroll
                            for (int j = 0; j < 4; ++j) acc[r][j] += sv * w[j]; } } }
#pragma unroll
                for (int r = 0; r < 9; ++r)
#pragma unroll
                    for (int j = 0; j < 4; ++j) red[(kk * 9 + r) * 48 + n4 * 4 + j] = acc[r][j];
            }
            __syncthreads();
            if (tid < 432) { const int r = tid / 48, n = tid % 48; float t = 0.f;
                for (int k2 = 0; k2 < 42; ++k2) t += red[(k2 * 9 + r) * 48 + n];
                ((float*)(ws + WS_MOD))[(size_t)(l * 9 + r) * 6144 + n0 + n] = t + bias[n0 + n]; }
            __syncthreads();
        }
    }
    for (int i = bid * 512 + tid; i < 64 * 512; i += G * 512) { const int p = i >> 9, j = i & 255; const float om = 1.0f / powf(10000.0f, (float)j * (1.0f / 256.0f)); const float ang = (float)p * om;
        ((float*)(ws + WS_PE))[i] = (i & 256) ? cosf(ang) : sinf(ang); }
    {
        LAS float* tile = (LAS float*)lds;
        constexpr int T0 = 512, T1 = T0 + 256, T2 = T1 + 1408, T3 = T2 + 704, T4 = T3 + 1408, T5 = T4 + 704, T6 = T5 + 64, T7 = T6 + 256;
        for (int t = bid; t < T7; t += G) {
            if (t < T0) { const int kt = t & 15, ntl = t >> 4; conv_tile(tile, a.in[9], 2048, kt * 64, ntl * 64, (bf16_t*)(ws + WS_WIN0), 1024, ntl * 64, kt * 64); }
            else if (t < T1) { const int u = t - T0, kt = u & 15, ntl = u >> 4; conv_tile(tile, a.in[17], 1024, kt * 64, ntl * 64, (bf16_t*)(ws + WS_WOUT0), 1024, ntl * 64, kt * 64); }
            else if (t < T2 || (t >= T3 && t < T4)) { const bool l1 = t >= T3; const int u = t - (l1 ? T3 : T1), kt = u & 15, ntl = u >> 4;
                const int n0 = ntl * 64, pn = n0 >> 8, bj = (n0 & 255) >> 7, j0 = n0 & 127, c0 = bj * DFF + pn * 128 + j0;
                conv_tile(tile, a.in[l1 ? 31 : 20], 2 * DFF, kt * 64, c0, (bf16_t*)(ws + (l1 ? WS_FIN1 : WS_FIN0)), 1024, n0, kt * 64, bj ? -0.69314718056f : -1.44269504089f); }
            else if (t < T3 || (t >= T4 && t < T5)) { const bool l1 = t >= T4; const int u = t - (l1 ? T4 : T2), kt = u % 44, ntl = u / 44;
                conv_tile(tile, a.in[l1 ? 32 : 21], 1024, kt * 64, ntl * 64, (bf16_t*)(ws + (l1 ? WS_FOUT1 : WS_FOUT0)), DFF, ntl * 64, kt * 64); }
            else if (t < T6) { const int u = t - T5, g = u >> 4, kt = u & 3, ntl = (u >> 2) & 3;
                conv_tile(tile, a.in[26] + (size_t)g * 65536, 256, kt * 64, ntl * 64, (bf16_t*)(ws + WS_POOLW), 256, g * 256 + ntl * 64, kt * 64); }
            else { const int u = t - T6, mtx = u >> 4, kt = u & 3, ntl = (u >> 2) & 3;
                const int dir = mtx >> 3, gate = (mtx >> 2) & 1, blk = mtx & 3;
                conv_tile(tile, a.in[gate ? 14 : 12] + (size_t)(dir * 4 + blk) * 65536, 256, kt * 64, ntl * 64, (bf16_t*)(ws + WS_WG) + (size_t)mtx * 65536, 256, ntl * 64, kt * 64, -1.44269504089f); }
        }
    }
}

template <int MODE>
__device__ __forceinline__ void rows_load(const float* xsrc, const bf16_t* Y, const float* PE, int row, int lane, f32x4 (&x)[4], u32x2 (&yw)[4], f32x4 (&pe)[4]) {
#pragma unroll
    for (int i = 0; i < 4; ++i) x[i] = (MODE == 0) ? __builtin_nontemporal_load((const f32x4*)(xsrc + (size_t)row * D + 4 * lane + 256 * i)) : *(const f32x4*)(xsrc + (size_t)row * D + 4 * lane + 256 * i);
    if (MODE == 0 || MODE == 4) { const int t = (row - NCTX) & 4095, pr = t >> 6, pc = t & 63;
#pragma unroll
        for (int i = 0; i < 4; ++i) { const int c = 4 * lane + 256 * i; pe[i] = *(const f32x4*)(PE + (size_t)((i < 2) ? pr : pc) * 512 + (c & 511)); }
    }
    if (MODE != 0) {
#pragma unroll
        for (int i = 0; i < 4; ++i) yw[i] = *(const u32x2*)(Y + (size_t)row * D + 4 * lane + 256 * i);
    }
}
template <int MODE>
__device__ __forceinline__ void rows_process(float* X, bf16_t* H, float* RSTD, int row, int lane, float pes, f32x4 (&x)[4], const u32x2 (&yw)[4], const f32x4 (&pe)[4],
                                             const f32x4 (&gp)[4], const f32x4 (&Gm)[4], const f32x4 (&Sm)[4]) {
    if (MODE == 0 || MODE == 4) {
#pragma unroll
        for (int i = 0; i < 4; ++i) x[i] = x[i] + pe[i] * pes;
    }
    if (MODE != 0) {
        float ss = 0.f; f32x4 y[4];
#pragma unroll
        for (int i = 0; i < 4; ++i) { y[i] = (f32x4){bf_lo(yw[i].x), bf_hi(yw[i].x), bf_lo(yw[i].y), bf_hi(yw[i].y)}; ss += (y[i][0] * y[i][0] + y[i][1] * y[i][1]) + (y[i][2] * y[i][2] + y[i][3] * y[i][3]); }
        ss = wave_sum(ss); const float ry = rsqrtf(ss * (1.0f / 1024.0f) + 1e-6f);
#pragma unroll
        for (int i = 0; i < 4; ++i) x[i] = x[i] + gp[i] * (y[i] * ry);
#pragma unroll
        for (int i = 0; i < 4; ++i) *(f32x4*)(X + (size_t)row * D + 4 * lane + 256 * i) = x[i];
    }
    if (MODE != 3) {
        float ss = 0.f;
#pragma unroll
        for (int i = 0; i < 4; ++i) ss += (x[i][0] * x[i][0] + x[i][1] * x[i][1]) + (x[i][2] * x[i][2] + x[i][3] * x[i][3]);
        ss = wave_sum(ss); const float rx = rsqrtf(ss * (1.0f / 1024.0f) + 1e-6f);
        if (MODE == 2) { if (lane == 0) RSTD[row] = rx; }
        else {
#pragma unroll
            for (int i = 0; i < 4; ++i) { const f32x4 h = (x[i] * rx) * Gm[i] + Sm[i]; u32x2 w; w.x = cvt_pk_bf16(h[0], h[1]); w.y = cvt_pk_bf16(h[2], h[3]);
                *(u32x2*)(H + (size_t)row * D + 4 * lane + 256 * i) = w; }
        }
    }
}
template <int MODE>
__device__ __forceinline__ void phase_rows(const Args& a, const float* modL_res  , int gate_idx, const float* post_g,
                           const float* modL_pre, int sh_idx, int sc_idx, const float* pre_g) {
    const int tid = threadIdx.x, lane = tid & 63, wid = tid >> 6;
    const int gw = blockIdx.x * 8 + wid, nw = gridDim.x * 8;
    float* X = a.out; bf16_t* H = (bf16_t*)(a.ws + WS_H); float* RSTD = (float*)(a.ws + WS_RSTD);
    const bf16_t* Y = (const bf16_t*)(a.ws + WS_Y); const float* PE = (const float*)(a.ws + WS_PE);
    const int rows_per = (TROWS + nw - 1) / nw;
    const int r_lo = gw * rows_per, r_hi = (r_lo + rows_per < TROWS) ? r_lo + rows_per : TROWS;
    int row = r_lo;
    while (row < r_hi) {
        const int cr = (row < NCTX) ? 0 : 1 + ((row - NCTX) >> 12);
        int seg_end = (cr == 0) ? NCTX : NCTX + cr * 4096; if (seg_end > r_hi) seg_end = r_hi;
        const float* xsrc = (MODE == 0 || MODE == 4) ? ((cr == 0) ? a.in[0] : a.in[1] - (size_t)NCTX * D) : (const float*)X;
        const float pes = (cr == 0) ? 0.f : 1.f;
        f32x4 gp[4], Gm[4], Sm[4];
#pragma unroll
        for (int i = 0; i < 4; ++i) { const int c = 4 * lane + 256 * i; gp[i] = (f32x4){0.f, 0.f, 0.f, 0.f}; Gm[i] = gp[i]; Sm[i] = gp[i];
            if (MODE != 0) { gp[i] = *(const f32x4*)(modL_res + (size_t)cr * 6144 + gate_idx * 1024 + c) * *(const f32x4*)(post_g + c); }
            if (MODE == 0 || MODE == 1 || MODE == 4) { Gm[i] = (*(const f32x4*)(modL_pre + (size_t)cr * 6144 + sc_idx * 1024 + c) + 1.0f) * *(const f32x4*)(pre_g + c); Sm[i] = *(const f32x4*)(modL_pre + (size_t)cr * 6144 + sh_idx * 1024 + c); } }
        f32x4 xa[4], xb[4], pa[4], pb[4]; u32x2 ya[4], yb[4];
#pragma unroll
        for (int i = 0; i < 4; ++i) { pa[i] = (f32x4){0.f, 0.f, 0.f, 0.f}; pb[i] = pa[i]; ya[i] = (u32x2){0u, 0u}; yb[i] = ya[i]; }
        rows_load<MODE>(xsrc, Y, PE, row, lane, xa, ya, pa);
        for (; row + 1 < seg_end; row += 2) {
            rows_load<MODE>(xsrc, Y, PE, row + 1, lane, xb, yb, pb);
            rows_process<MODE>(X, H, RSTD, row, lane, pes, xa, ya, pa, gp, Gm, Sm);
            rows_load<MODE>(xsrc, Y, PE, (row + 2 < seg_end) ? row + 2 : row + 1, lane, xa, ya, pa);
            rows_process<MODE>(X, H, RSTD, row + 1, lane, pes, xb, yb, pb, gp, Gm, Sm);
        }
        if (row < seg_end) { rows_process<MODE>(X, H, RSTD, row, lane, pes, xa, ya, pa, gp, Gm, Sm); ++row; }
    }
}

template <bool SRC_IN, bool HAS_Y2>
__device__ __forceinline__ void rows2_load(const float* xsrc, const bf16_t* Y1, const bf16_t* Y2, const float* PE, int row, int lane, f32x4 (&x)[4], u32x2 (&y1)[4], u32x2 (&y2)[4], f32x4 (&pe)[4]) {
#pragma unroll
    for (int i = 0; i < 4; ++i) x[i] = SRC_IN ? __builtin_nontemporal_load((const f32x4*)(xsrc + (size_t)row * D + 4 * lane + 256 * i)) : *(const f32x4*)(xsrc + (size_t)row * D + 4 * lane + 256 * i);
    if (SRC_IN) { const int t = (row - NCTX) & 4095, pr = t >> 6, pc = t & 63;
#pragma unroll
        for (int i = 0; i < 4; ++i) { const int c = 4 * lane + 256 * i; pe[i] = *(const f32x4*)(PE + (size_t)((i < 2) ? pr : pc) * 512 + (c & 511)); }
    }
#pragma unroll
    for (int i = 0; i < 4; ++i) y1[i] = *(const u32x2*)(Y1 + (size_t)row * D + 4 * lane + 256 * i);
    if (HAS_Y2) {
#pragma unroll
        for (int i = 0; i < 4; ++i) y2[i] = __builtin_nontemporal_load((const u32x2*)(Y2 + (size_t)row * D + 4 * lane + 256 * i));
    }
}
__device__ __forceinline__ void rows2_addbranch(f32x4 (&x)[4], const u32x2 (&yw)[4], const f32x4 (&gp)[4]) {
    float ss = 0.f; f32x4 y[4];
#pragma unroll
    for (int i = 0; i < 4; ++i) { y[i] = (f32x4){bf_lo(yw[i].x), bf_hi(yw[i].x), bf_lo(yw[i].y), bf_hi(yw[i].y)}; ss += (y[i][0] * y[i][0] + y[i][1] * y[i][1]) + (y[i][2] * y[i][2] + y[i][3] * y[i][3]); }
    ss = wave_sum(ss); const float ry = rsqrtf(ss * (1.0f / 1024.0f) + 1e-6f);
#pragma unroll
    for (int i = 0; i < 4; ++i) x[i] = x[i] + gp[i] * (y[i] * ry);
}
template <bool SRC_IN, bool HAS_Y2, int OUT>
__device__ __forceinline__ void rows2_process(float* X, bf16_t* H, float* RSTD, int row, int lane, float pes, f32x4 (&x)[4], const u32x2 (&y1)[4], const u32x2 (&y2)[4], const f32x4 (&pe)[4],
                                              const f32x4 (&gp1)[4], const f32x4 (&gp2)[4], const f32x4 (&Gm)[4], const f32x4 (&Sm)[4]) {
    if (SRC_IN) {
#pragma unroll
        for (int i = 0; i < 4; ++i) x[i] = x[i] + pe[i] * pes;
    }
    rows2_addbranch(x, y1, gp1);
    if (HAS_Y2) {
        rows2_addbranch(x, y2, gp2);
#pragma unroll
        for (int i = 0; i < 4; ++i) { if (OUT == 2) __builtin_nontemporal_store(x[i], (f32x4*)(X + (size_t)row * D + 4 * lane + 256 * i)); else *(f32x4*)(X + (size_t)row * D + 4 * lane + 256 * i) = x[i]; }
    }
    if (!HAS_Y2 || OUT == 1) {
        float ss = 0.f;
#pragma unroll
        for (int i = 0; i < 4; ++i) ss += (x[i][0] * x[i][0] + x[i][1] * x[i][1]) + (x[i][2] * x[i][2] + x[i][3] * x[i][3]);
        ss = wave_sum(ss); const float rx = rsqrtf(ss * (1.0f / 1024.0f) + 1e-6f);
        if (HAS_Y2) { if (lane == 0) RSTD[row] = rx; }
        else {
#pragma unroll
            for (int i = 0; i < 4; ++i) { const f32x4 h = (x[i] * rx) * Gm[i] + Sm[i]; u32x2 w; w.x = cvt_pk_bf16(h[0], h[1]); w.y = cvt_pk_bf16(h[2], h[3]);
                *(u32x2*)(H + (size_t)row * D + 4 * lane + 256 * i) = w; }
        }
    }
}
template <bool SRC_IN, bool HAS_Y2, int OUT>
__device__ __forceinline__ void phase_rows2(const Args& a, const float* modL  , const float* post1, const float* post2, const float* pre_g) {
    const int tid = threadIdx.x, lane = tid & 63, wid = tid >> 6;
    const int gw = blockIdx.x * 8 + wid, nw = gridDim.x * 8;
    float* X = a.out; bf16_t* H = (bf16_t*)(a.ws + WS_H); float* RSTD = (float*)(a.ws + WS_RSTD);
    const bf16_t* Y1 = (const bf16_t*)(a.ws + WS_Y1); const bf16_t* Y2 = (const bf16_t*)(a.ws + WS_Y); const float* PE = (const float*)(a.ws + WS_PE);
    const int rows_per = (TROWS + nw - 1) / nw;
    const int r_lo = gw * rows_per, r_hi = (r_lo + rows_per < TROWS) ? r_lo + rows_per : TROWS;
    int row = r_lo;
    while (row < r_hi) {
        const int cr = (row < NCTX) ? 0 : 1 + ((row - NCTX) >> 12);
        int seg_end = (cr == 0) ? NCTX : NCTX + cr * 4096; if (seg_end > r_hi) seg_end = r_hi;
        const float* xsrc = SRC_IN ? ((cr == 0) ? a.in[0] : a.in[1] - (size_t)NCTX * D) : (const float*)X;
        const float pes = (cr == 0) ? 0.f : 1.f;
        f32x4 gp1[4], gp2[4], Gm[4], Sm[4];
#pragma unroll
        for (int i = 0; i < 4; ++i) { const int c = 4 * lane + 256 * i; gp2[i] = (f32x4){0.f, 0.f, 0.f, 0.f}; Gm[i] = gp2[i]; Sm[i] = gp2[i];
            gp1[i] = *(const f32x4*)(modL + (size_t)cr * 6144 + 2 * 1024 + c) * *(const f32x4*)(post1 + c);
            if (HAS_Y2) gp2[i] = *(const f32x4*)(modL + (size_t)cr * 6144 + 5 * 1024 + c) * *(const f32x4*)(post2 + c);
            else { Gm[i] = (*(const f32x4*)(modL + (size_t)cr * 6144 + 4 * 1024 + c) + 1.0f) * *(const f32x4*)(pre_g + c); Sm[i] = *(const f32x4*)(modL + (size_t)cr * 6144 + 3 * 1024 + c); } }
        f32x4 xa[4], xb[4], pa[4], pb[4]; u32x2 y1a[4], y1b[4], y2a[4], y2b[4];
#pragma unroll
        for (int i = 0; i < 4; ++i) { pa[i] = (f32x4){0.f, 0.f, 0.f, 0.f}; pb[i] = pa[i]; y2a[i] = (u32x2){0u, 0u}; y2b[i] = y2a[i]; }
        rows2_load<SRC_IN, HAS_Y2>(xsrc, Y1, Y2, PE, row, lane, xa, y1a, y2a, pa);
        for (; row + 1 < seg_end; row += 2) {
            rows2_load<SRC_IN, HAS_Y2>(xsrc, Y1, Y2, PE, row + 1, lane, xb, y1b, y2b, pb);
            rows2_process<SRC_IN, HAS_Y2, OUT>(X, H, RSTD, row, lane, pes, xa, y1a, y2a, pa, gp1, gp2, Gm, Sm);
            rows2_load<SRC_IN, HAS_Y2>(xsrc, Y1, Y2, PE, (row + 2 < seg_end) ? row + 2 : row + 1, lane, xa, y1a, y2a, pa);
            rows2_process<SRC_IN, HAS_Y2, OUT>(X, H, RSTD, row + 1, lane, pes, xb, y1b, y2b, pb, gp1, gp2, Gm, Sm);
        }
        if (row < seg_end) { rows2_process<SRC_IN, HAS_Y2, OUT>(X, H, RSTD, row, lane, pes, xa, y1a, y2a, pa, gp1, gp2, Gm, Sm); ++row; }
    }
}

constexpr int UROW = 528;
__device__ __forceinline__ void phase_scan(const Args& a, LAS unsigned char* lds) {
    const int tid = threadIdx.x, lane = tid & 63, wid = tid >> 6, q = lane >> 4, cl = lane & 15;
    const int hb = blockIdx.x & 7, cb = hb >> 1;
    const int ewave = (hb & 1) * 128 + wid * 16;
    const int ch = cb * 256 + ewave + cl;
    const bf16_t* REC = (const bf16_t*)(a.ws + WS_REC); const bf16_t* WG = (const bf16_t*)(a.ws + WS_WG);
    float* AGG = (float*)(a.ws + WS_AGG);
    float bA[2], bX[2], c8[2];
#pragma unroll
    for (int d = 0; d < 2; ++d) { bA[d] = -1.44269504089f * a.in[13][d * 1024 + ch]; bX[d] = -1.44269504089f * a.in[15][d * 1024 + ch];
        const float lam = a.in[16][d * 1024 + ch]; c8[d] = -8.0f * log1pf(expf(-lam)) * 1.44269504089f; }
    const int ch8 = tid & 31, rgrp = tid >> 5;
    const int loff = q * 4 * 1024 + ch;
    const int nblk = gridDim.x >> 3;
    for (int ck = blockIdx.x >> 3; ck < NCHUNK; ck += nblk) {
        int cis, nch, seqrow0;
        if (ck < 32) { cis = ck & 1; nch = 2; seqrow0 = (ck >> 1) * 256; }
        else { const int k2 = ck - 32; cis = k2 & 31; nch = 32; seqrow0 = NCTX + (k2 >> 5) * 4096; }
        const int t0 = cis * 128, T = nch * 128, row0 = seqrow0 + t0;
        __syncthreads();
        {
            const bf16_t* rp = REC + (size_t)seqrow0 * 1024 + cb * 256 + ch8 * 8;
            u32x4 wv[11];
            f32x4 cwv[4][2], cbv[2];
#pragma unroll
            for (int h2 = 0; h2 < 2; ++h2) { cbv[h2] = *(const f32x4*)(a.in[11] + cb * 256 + ch8 * 8 + 4 * h2);
#pragma unroll
                for (int k = 0; k < 4; ++k) cwv[k][h2] = *(const f32x4*)(a.in[10] + k * 1024 + cb * 256 + ch8 * 8 + 4 * h2); }
#pragma unroll
            for (int i = 0; i < 11; ++i) { const int tr = t0 + rgrp * 8 - 2 + i; const int trc = tr < 0 ? 0 : (tr >= T ? T - 1 : tr);
                const unsigned msk = (tr < 0 || tr >= T) ? 0u : 0xffffffffu;
                wv[i] = *(const u32x4*)(rp + (size_t)trc * 1024) & msk; }
            float prev[3][8] = {};
#pragma unroll
            for (int i = 0; i < 11; ++i) {
                const u32x4 w0 = wv[i]; float v[8];
                v[0] = bf_lo(w0.x); v[1] = bf_hi(w0.x); v[2] = bf_lo(w0.y); v[3] = bf_hi(w0.y); v[4] = bf_lo(w0.z); v[5] = bf_hi(w0.z); v[6] = bf_lo(w0.w); v[7] = bf_hi(w0.w);
                if (i >= 3) { float u[8];
#pragma unroll
                    for (int j = 0; j < 8; ++j) u[j] = cbv[j >> 2][j & 3] + cwv[0][j >> 2][j & 3] * prev[0][j] + cwv[1][j >> 2][j & 3] * prev[1][j] + cwv[2][j >> 2][j & 3] * prev[2][j] + cwv[3][j >> 2][j & 3] * v[j];
                    u32x4 w; w.x = cvt_pk_bf16(u[0], u[1]); w.y = cvt_pk_bf16(u[2], u[3]); w.z = cvt_pk_bf16(u[4], u[5]); w.w = cvt_pk_bf16(u[6], u[7]);
                    *(LAS u32x4*)(lds + (rgrp * 8 + i - 3) * UROW + ch8 * 16) = w; }
#pragma unroll
                for (int j = 0; j < 8; ++j) { prev[0][j] = prev[1][j]; prev[1][j] = prev[2][j]; prev[2][j] = v[j]; }
            }
        }
        bf16x8 Bf[2][8];
#pragma unroll
        for (int g = 0; g < 2; ++g)
#pragma unroll
            for (int ks = 0; ks < 8; ++ks) Bf[g][ks] = *(const bf16x8*)(WG + ((size_t)((0 * 2 + g) * 4 + cb) * 256 + ewave + cl) * 256 + ks * 32 + q * 8);
        __syncthreads();
#pragma unroll
        for (int dir = 0; dir < 2; ++dir) {
            if (dir == 1) {
#pragma unroll
                for (int g = 0; g < 2; ++g)
#pragma unroll
                    for (int ks = 0; ks < 8; ++ks) Bf[g][ks] = *(const bf16x8*)(WG + ((size_t)((1 * 2 + g) * 4 + cb) * 256 + ewave + cl) * 256 + ks * 32 + q * 8);
            }
            const int p = dir ? 3 - q : q;
            float Atot = 1.f, Btot = 0.f;
            unsigned* const dbase = (unsigned*)(a.ws + (dir ? WS_DBB : WS_DBF)) + (size_t)row0 * 1024;
            f32x4 nA = (f32x4){bA[dir], bA[dir], bA[dir], bA[dir]}, nX = (f32x4){bX[dir], bX[dir], bX[dir], bX[dir]};
            { const int m0 = dir ? 7 : 0;
#pragma unroll
              for (int ks = 0; ks < 8; ++ks) { const bf16x8 Af = *(const LAS bf16x8*)(lds + (16 * m0 + cl) * UROW + (ks * 32 + q * 8) * 2);
                  nA = __builtin_amdgcn_mfma_f32_16x16x32_bf16(Af, Bf[0][ks], nA, 0, 0, 0); nX = __builtin_amdgcn_mfma_f32_16x16x32_bf16(Af, Bf[1][ks], nX, 0, 0, 0); } }
#pragma unroll 1
            for (int mm = 0; mm < 8; ++mm) {
                const int m = dir ? 7 - mm : mm;
                const f32x4 accA = nA, accX = nX;
                { const int mn = (mm < 7) ? (dir ? 6 - mm : mm + 1) : m;
                  nA = (f32x4){bA[dir], bA[dir], bA[dir], bA[dir]}; nX = (f32x4){bX[dir], bX[dir], bX[dir], bX[dir]};
#pragma unroll
                  for (int ks = 0; ks < 8; ++ks) { const bf16x8 Af = *(const LAS bf16x8*)(lds + (16 * mn + cl) * UROW + (ks * 32 + q * 8) * 2);
                      nA = __builtin_amdgcn_mfma_f32_16x16x32_bf16(Af, Bf[0][ks], nA, 0, 0, 0); nX = __builtin_amdgcn_mfma_f32_16x16x32_bf16(Af, Bf[1][ks], nX, 0, 0, 0); } }
                unsigned* const drow = dbase + (size_t)(16 * m) * 1024;
                float aa[4], bb[4];
#pragma unroll
                for (int j = 0; j < 4; ++j) {
                    const float uval = __uint_as_float(((unsigned)*(const LAS unsigned short*)(lds + (16 * m + 4 * q + j) * UROW + (ewave + cl) * 2)) << 16);
                    const float t1 = 1.0f + __builtin_amdgcn_exp2f(accA[j]), t2 = 1.0f + __builtin_amdgcn_exp2f(accX[j]), inv = __builtin_amdgcn_rcpf(t1 * t2);
                    const float av = __builtin_amdgcn_exp2f(c8[dir] * (t2 * inv));
                    const float dv = 1.0f - av, bv = __builtin_amdgcn_sqrtf(fmaxf(dv * (1.0f + av), 0.f)) * ((t1 * inv) * uval);
                    __builtin_nontemporal_store(cvt_pk_bf16(dv, bv), drow + loff + j * 1024);
                    aa[j] = av; bb[j] = bv;
                }
                float Al = 1.f, Bl = 0.f;
#pragma unroll
                for (int jj = 0; jj < 4; ++jj) { const int j = dir ? 3 - jj : jj; Bl = aa[j] * Bl + bb[j]; Al *= aa[j]; }
                const float Ao = xchg16(Al, (q & 1) != 0), Bo = xchg16(Bl, (q & 1) != 0);
                const bool first = !(p & 1);
                const float A1 = first ? Al : Ao, B1 = first ? Bl : Bo, A2 = first ? Ao : Al, B2 = first ? Bo : Bl;
                const float Ap = A1 * A2, Bp = A2 * B1 + B2;
                const float Aq = xchg32(Ap, q >= 2), Bq = xchg32(Bp, q >= 2);
                const bool fp = !(p & 2);
                const float A01 = fp ? Ap : Aq, B01 = fp ? Bp : Bq, A23 = fp ? Aq : Ap, B23 = fp ? Bq : Bp;
                const float At = A01 * A23, Bt = A23 * B01 + B23;
                Btot = At * Btot + Bt; Atot *= At;
            }
            if (q == 0) { float* aA = AGG + (size_t)(dir * NCHUNK + ck) * 1024 + ch; aA[0] = Atot; aA[(size_t)2 * NCHUNK * 1024] = Btot; }
        }
    }
}

__device__ __forceinline__ void phase_apply(const Args& a) {
    const unsigned* DBF = (const unsigned*)(a.ws + WS_DBF); const unsigned* DBB = (const unsigned*)(a.ws + WS_DBB);
    const bf16_t* GACT = (const bf16_t*)(a.ws + WS_GACT); bf16_t* MIX = (bf16_t*)(a.ws + WS_REC); const float* CAR = (const float*)(a.ws + WS_CAR);
    for (int it = blockIdx.x; it < NCHUNK * 2; it += gridDim.x) {
        const int ck = it >> 1, ch = (it & 1) * 512 + threadIdx.x; const size_t o0 = (size_t)ck * 128 * 1024 + ch;
        float hf[128];
        {
            float h = CAR[(size_t)(0 * NCHUNK + ck) * 1024 + ch];
            unsigned w[16], wn[16];
#pragma unroll
            for (int j = 0; j < 16; ++j) { w[j] = __builtin_nontemporal_load(DBF + (o0 + (size_t)j * 1024)); wn[j] = 0u; }
#pragma unroll
            for (int blk = 0; blk < 8; ++blk) {
                if (blk < 7) {
#pragma unroll
                    for (int j = 0; j < 16; ++j) wn[j] = __builtin_nontemporal_load(DBF + (o0 + (size_t)((blk + 1) * 16 + j) * 1024));
                }
#pragma unroll
                for (int j = 0; j < 16; ++j) { h = __builtin_fmaf(-bf_lo(w[j]), h, h) + bf_hi(w[j]); hf[blk * 16 + j] = h; }
#pragma unroll
                for (int j = 0; j < 16; ++j) w[j] = wn[j];
            }
        }
        {
            float h = CAR[(size_t)(1 * NCHUNK + ck) * 1024 + ch];
            unsigned w[16], wn[16]; unsigned short g[16], gn[16];
#pragma unroll
            for (int j = 0; j < 16; ++j) { w[j] = __builtin_nontemporal_load(DBB + (o0 + (size_t)(7 * 16 + j) * 1024)); g[j] = __builtin_nontemporal_load(GACT + (o0 + (size_t)(7 * 16 + j) * 1024)); wn[j] = 0u; gn[j] = 0; }
#pragma unroll
            for (int blk = 7; blk >= 0; --blk) {
                if (blk > 0) {
#pragma unroll
                    for (int j = 0; j < 16; ++j) { wn[j] = __builtin_nontemporal_load(DBB + (o0 + (size_t)((blk - 1) * 16 + j) * 1024)); gn[j] = __builtin_nontemporal_load(GACT + (o0 + (size_t)((blk - 1) * 16 + j) * 1024)); }
                }
#pragma unroll
                for (int j = 15; j >= 0; --j) { h = __builtin_fmaf(-bf_lo(w[j]), h, h) + bf_hi(w[j]);
                    const float mv = (hf[blk * 16 + j] + h) * __uint_as_float(((unsigned)g[j]) << 16);
                    MIX[o0 + (size_t)(blk * 16 + j) * 1024] = (bf16_t)(cvt_pk_bf16(mv, 0.f) & 0xffffu); }
#pragma unroll
                for (int j = 0; j < 16; ++j) { w[j] = wn[j]; g[j] = gn[j]; }
            }
        }
    }
}

__device__ __forceinline__ void phase_carry(const Args& a) {
    const float* AGG = (const float*)(a.ws + WS_AGG); float* CAR = (float*)(a.ws + WS_CAR);
    for (int id = blockIdx.x * 512 + threadIdx.x; id < 24 * 2 * 1024; id += gridDim.x * 512) {
        const int ch = id & 1023, dir = (id >> 10) & 1, s = id >> 11;
        const bool lat = s >= 16; const int nch = lat ? 32 : 2, ck0 = lat ? 32 + (s - 16) * 32 : s * 2;
        float h = lat ? a.in[2][(size_t)((s - 16) * 2 + dir) * 1024 + ch] : 0.f;
        const float* aA = AGG + (size_t)(dir * NCHUNK + ck0) * 1024 + ch; const float* aB = aA + (size_t)2 * NCHUNK * 1024;
        float* cr = CAR + (size_t)(dir * NCHUNK + ck0) * 1024 + ch;
        float A[32], B[32];
#pragma unroll
        for (int k = 0; k < 32; ++k) { const int kk = k < nch ? k : nch - 1; A[k] = aA[(size_t)kk * 1024]; B[k] = aB[(size_t)kk * 1024]; }
        if (dir == 0) {
#pragma unroll
            for (int k = 0; k < 32; ++k) if (k < nch) { cr[(size_t)k * 1024] = h; h = A[k] * h + B[k]; }
        } else {
#pragma unroll
            for (int k = 31; k >= 0; --k) if (k < nch) { cr[(size_t)k * 1024] = h; h = A[k] * h + B[k]; }
        }
        if (!lat) a.out[(size_t)TROWS * 1024 + (size_t)(s * 2 + dir) * 1024 + ch] = h;
    }
}

template <int HALF>
__device__ __forceinline__ void pool_item(const float* X, const float* RSTD, bf16_t* P, int seqrow0, int T, int t0, int c, f32x2 Gm) {
    constexpr int NV = 16 + 2 * HALF;
    f32x2 v[NV];
#pragma unroll
    for (int i = 0; i < NV; ++i) { const int tt = t0 - HALF + i; const int tc = tt < 0 ? 0 : (tt >= T ? T - 1 : tt); const size_t r = (size_t)(seqrow0 + tc);
        const float vm = (tt < 0 || tt >= T) ? 0.f : RSTD[r];
        v[i] = *(const f32x2*)(X + r * D + c) * vm; }
    f32x2 S = (f32x2){0.f, 0.f};
#pragma unroll
    for (int i = 0; i < 2 * HALF; ++i) S += v[i];
#pragma unroll
    for (int j = 0; j < 16; ++j) { const int t = t0 + j; const int lo = (t - HALF) < 0 ? 0 : (t - HALF), hi = (t + HALF) > T ? T : (t + HALF);
        const f32x2 o = Gm * (S * (1.0f / (float)(hi - lo)) - v[j + HALF]);
        *(unsigned*)(P + (size_t)(seqrow0 + t) * D + c) = cvt_pk_bf16(o[0], o[1]);
        if (j < 15) S += v[j + 2 * HALF] - v[j]; }
}
__device__ __forceinline__ void phase_pool(const Args& a) {
    const int tid = threadIdx.x;
    const float* X = a.out; const float* RSTD = (const float*)(a.ws + WS_RSTD); bf16_t* P = (bf16_t*)(a.ws + WS_H);
    const float* MOD1 = (const float*)(a.ws + WS_MOD) + (size_t)9 * 6144;
    const int c = 2 * tid, g = tid >> 7;
    const f32x2 pg = *(const f32x2*)(a.in[24] + c);
    for (int it = blockIdx.x; it < TROWS / 16; it += gridDim.x) {
        const int row0 = it * 16;
        int seqrow0, T, cr;
        if (row0 < NCTX) { seqrow0 = row0 & ~255; T = 256; cr = 0; } else { const int lr = row0 - NCTX; seqrow0 = NCTX + (lr & ~4095); T = 4096; cr = 1 + (lr >> 12); }
        const f32x2 Gm = (*(const f32x2*)(MOD1 + (size_t)cr * 6144 + 1 * 1024 + c) + 1.0f) * pg;
        const int t0 = row0 - seqrow0;
        if (g == 0) pool_item<1>(X, RSTD, P, seqrow0, T, t0, c, Gm);
        else if (g == 1) pool_item<2>(X, RSTD, P, seqrow0, T, t0, c, Gm);
        else if (g == 2) pool_item<4>(X, RSTD, P, seqrow0, T, t0, c, Gm);
        else pool_item<8>(X, RSTD, P, seqrow0, T, t0, c, Gm);
    }
}

constexpr int XNROW = 260;
__device__ __forceinline__ void phase_poolmm(const Args& a, LAS unsigned char* lds) {
    const int tid = threadIdx.x, lane = tid & 63, wid = tid >> 6, q = lane >> 4, cl = lane & 15;
    const int g = blockIdx.x & 3, h = 1 << g;
    const float* X = a.out; const float* RSTD = (const float*)(a.ws + WS_RSTD); bf16_t* Y1 = (bf16_t*)(a.ws + WS_Y1);
    const float* MOD1 = (const float*)(a.ws + WS_MOD) + (size_t)9 * 6144;
    const bf16_t* WP = (const bf16_t*)(a.ws + WS_POOLW);
    LAS float* xnl = (LAS float*)lds;
    LAS unsigned char* pl = lds + 80 * XNROW * 4;
    bf16x8 Bf[2][8];
#pragma unroll
    for (int nt = 0; nt < 2; ++nt)
#pragma unroll
        for (int ks = 0; ks < 8; ++ks) Bf[nt][ks] = *(const bf16x8*)(WP + ((size_t)(g * 256 + wid * 32 + nt * 16 + cl)) * 256 + ks * 32 + q * 8);
    float pb[2], ps[2];
#pragma unroll
    for (int nt = 0; nt < 2; ++nt) { const int chn = g * 256 + wid * 32 + nt * 16 + cl; pb[nt] = a.in[27][chn]; ps[nt] = a.in[28][chn]; }
    const int c2 = tid & 127, tq = tid >> 7;
    const f32x2 pg = *(const f32x2*)(a.in[24] + g * 256 + 2 * c2);
    const int srow = tid >> 6, sc4 = tid & 63;
    const int nblk = gridDim.x >> 2;
    f32x4 xv[10]; float vmv[10];
#define PM_ISSUE(ttx) do { const int r0_ = (ttx) * 64; int s0_, s1_; if (r0_ < NCTX) { s0_ = r0_ & ~255; s1_ = s0_ + 256; } else { const int lr_ = r0_ - NCTX; s0_ = NCTX + (lr_ & ~4095); s1_ = s0_ + 4096; } \
        _Pragma("unroll") for (int i = 0; i < 10; ++i) { const int r = r0_ - 8 + srow + 8 * i; const int rc = r < s0_ ? s0_ : (r >= s1_ ? s1_ - 1 : r); \
            vmv[i] = (r < s0_ || r >= s1_) ? 0.f : RSTD[rc]; xv[i] = *(const f32x4*)(X + (size_t)rc * D + g * 256 + sc4 * 4); } } while (0)
    int tt = blockIdx.x >> 2;
    if (tt < TROWS / 64) PM_ISSUE(tt);
    for (; tt < TROWS / 64; tt += nblk) {
        const int r0 = tt * 64; int s0, s1, cr;
        if (r0 < NCTX) { s0 = r0 & ~255; s1 = s0 + 256; cr = 0; } else { const int lr = r0 - NCTX; s0 = NCTX + (lr & ~4095); s1 = s0 + 4096; cr = 1 + (lr >> 12); }
        __syncthreads();
#pragma unroll
        for (int i = 0; i < 10; ++i) *(LAS f32x4*)(xnl + (srow + 8 * i) * XNROW + sc4 * 4) = xv[i] * vmv[i];
        __syncthreads();
        {
            const f32x2 Gm = (*(const f32x2*)(MOD1 + (size_t)cr * 6144 + 1 * 1024 + g * 256 + 2 * c2) + 1.0f) * pg;
            const int tl0 = tq * 16;
            f32x2 S = (f32x2){0.f, 0.f};
            for (int d = -h; d < h; ++d) S += *(const LAS f32x2*)(xnl + (tl0 + 8 + d) * XNROW + 2 * c2);
#pragma unroll 4
            for (int j = 0; j < 16; ++j) { const int tl = tl0 + j, t = r0 + tl; const int lo = (t - h) < s0 ? s0 : (t - h), hi = (t + h) > s1 ? s1 : (t + h);
                const f32x2 xc = *(const LAS f32x2*)(xnl + (tl + 8) * XNROW + 2 * c2);
                const f32x2 o = Gm * (S * (1.0f / (float)(hi - lo)) - xc);
                *(LAS unsigned*)(pl + tl * UROW + c2 * 4) = cvt_pk_bf16(o[0], o[1]);
                S += *(const LAS f32x2*)(xnl + (tl + 8 + h) * XNROW + 2 * c2) - *(const LAS f32x2*)(xnl + (tl + 8 - h) * XNROW + 2 * c2); }
        }
        { const int ttn = (tt + nblk < TROWS / 64) ? tt + nblk : tt; PM_ISSUE(ttn); }
        __syncthreads();
#pragma unroll 1
        for (int m = 0; m < 4; ++m) {
            f32x4 acc[2] = {(f32x4){0.f, 0.f, 0.f, 0.f}, (f32x4){0.f, 0.f, 0.f, 0.f}};
#pragma unroll
            for (int ks = 0; ks < 8; ++ks) { const bf16x8 Af = *(const LAS bf16x8*)(pl + (16 * m + cl) * UROW + (ks * 32 + q * 8) * 2);
                acc[0] = __builtin_amdgcn_mfma_f32_16x16x32_bf16(Af, Bf[0][ks], acc[0], 0, 0, 0); acc[1] = __builtin_amdgcn_mfma_f32_16x16x32_bf16(Af, Bf[1][ks], acc[1], 0, 0, 0); }
            bf16_t* const yrow = Y1 + (size_t)(r0 + 16 * m) * 1024;
#pragma unroll
            for (int nt = 0; nt < 2; ++nt)
#pragma unroll
                for (int j = 0; j < 4; ++j) yrow[(4 * q + j) * 1024 + g * 256 + wid * 32 + nt * 16 + cl] = (bf16_t)(cvt_pk_bf16((acc[nt][j] + pb[nt]) * ps[nt], 0.f) & 0xffffu);
        }
    }
#undef PM_ISSUE
}

__global__ void __launch_bounds__(512, 2) mk_fwd(Args a) {
    extern __shared__ __attribute__((aligned(16))) unsigned char lds_raw[];
    LAS unsigned char* lds = (LAS unsigned char*)lds_raw;
    unsigned char* ws = a.ws;
    const float* MOD0 = (const float*)(ws + WS_MOD); const float* MOD1 = MOD0 + (size_t)9 * 6144;
    bf16_t* Hb = (bf16_t*)(ws + WS_H); bf16_t* Yb = (bf16_t*)(ws + WS_Y); bf16_t* Bb = (bf16_t*)(ws + WS_B);
    const int lo = a.ph_lo, hi = a.ph_hi;
    volatile LAS unsigned* bst = (volatile LAS unsigned*)(lds + LDS_BYTES - 16);
    if (threadIdx.x < 4) bst[threadIdx.x] = 0u;
    __syncthreads();
    XcdBarrier bar; bar.bar = (unsigned*)(ws + WS_BAR); bar.x = 0; bar.st = bst;
    if (hi - lo > 1) bar = xcd_barrier_post((unsigned*)(ws + WS_BAR), bst);
    if (hi > NPH) cg::this_grid().sync();
#define GRID_BAR() xcd_barrier(bar)
#define IN(k) ((PH_MASK & (1 << (k))) && lo <= (k) && (k) < hi)
#define SEAM(k) do { if (lo <= (k) && (k) + 1 < hi) GRID_BAR(); } while (0)
#define REPS(k) (((REP_MASK) >> (k)) & 1 ? 2 : 1)
#define RUN_GEMM(k, tl) do { for (int rep_ = 0; rep_ < REPS(k); ++rep_) { pg8::StaticOrder S; S.init(g.M, g.N, g.K, (int)gridDim.x, (int)blockIdx.x, tl); pg8::gemm_phase(lds, g, S, E); if (rep_ + 1 < REPS(k)) GRID_BAR(); } } while (0)
#define RUN(k, call) do { if (IN(k)) for (int rep_ = 0; rep_ < REPS(k); ++rep_) { call; if (rep_ + 1 < REPS(k)) GRID_BAR(); } SEAM(k); } while (0)
    float* const PARTp = (float*)(ws + WS_H);
    RUN(0, phase_prologue(a, lds));
    RUN(1, phase_rows<0>(a, nullptr, 0, nullptr, MOD0, 0, 1, a.in[7]));
    if (IN(2)) { pg8::Gemm g{Hb, (const bf16_t*)(ws + WS_WIN0), TROWS, 2048, 1024, 1024, 0}; pg8::Epi E{0, (bf16_t*)(ws + WS_GACT), (bf16_t*)(ws + WS_REC), nullptr, nullptr, nullptr, 16}; RUN_GEMM(2, 0); }
    SEAM(2);
    RUN(3, phase_scan(a, lds));
    RUN(4, phase_carry(a));
    RUN(5, phase_apply(a));
    if (IN(6)) { pg8::Gemm g{(const bf16_t*)(ws + WS_REC), (const bf16_t*)(ws + WS_WOUT0), TROWS, 1024, 1024, 1024, 0}; pg8::Epi E{1, (bf16_t*)(ws + WS_Y1), nullptr, nullptr, nullptr, nullptr, 16}; RUN_GEMM(6, 0); }
    SEAM(6);
    if (IN(7)) phase_rows2<true, false, 0>(a, MOD0, a.in[8], nullptr, a.in[18]);
    SEAM(7);
    if (IN(8)) { pg8::Gemm g{Hb, (const bf16_t*)(ws + WS_FIN0), TROWS, 2 * DFF, 1024, 1024, 0}; pg8::Epi E{2, Bb, nullptr, nullptr, nullptr, nullptr, 16}; RUN_GEMM(8, 0); }
    SEAM(8);
    if (IN(9)) { pg8::Gemm g{Bb, (const bf16_t*)(ws + WS_FOUT0), TROWS, 1024, DFF, DFF, 0}; pg8::Epi E{1, Yb, nullptr, nullptr, nullptr, PARTp, 44}; RUN_GEMM(9, 3); }
    SEAM(9);
    if (IN(10)) tail_reduce(PARTp, Yb);
    SEAM(10);
    if (IN(11)) phase_rows2<true, true, 1>(a, MOD0, a.in[8], a.in[19], nullptr);
    SEAM(11);
    RUN(12, phase_poolmm(a, lds));
    if (IN(14)) phase_rows2<false, false, 0>(a, MOD1, a.in[25], nullptr, a.in[29]);
    SEAM(14);
    if (IN(15)) { pg8::Gemm g{Hb, (const bf16_t*)(ws + WS_FIN1), TROWS, 2 * DFF, 1024, 1024, 0}; pg8::Epi E{2, Bb, nullptr, nullptr, nullptr, nullptr, 16}; RUN_GEMM(15, 0); }
    SEAM(15);
    if (IN(16)) { pg8::Gemm g{Bb, (const bf16_t*)(ws + WS_FOUT1), TROWS, 1024, DFF, DFF, 0}; pg8::Epi E{1, Yb, nullptr, nullptr, nullptr, PARTp, 44}; RUN_GEMM(16, 3); }
    SEAM(16);
    if (IN(17)) tail_reduce(PARTp, Yb);
    SEAM(17);
    if (IN(18)) phase_rows2<false, true, 2>(a, MOD1, a.in[25], a.in[30], nullptr);
#undef RUN
#undef GRID_BAR
#undef IN
#undef SEAM
#undef RUN_GEMM
#undef REPS
}

extern "C" void kernel_launch(void* const* d_in, const int* in_sizes, int n_in, void* d_out, int out_size, void* d_ws, size_t ws_size, hipStream_t stream) {
    static int grid = 0;
    if (grid == 0) {
        if (n_in != 33 || ws_size < WS_END) { fprintf(stderr, "kernel_launch: need 33 inputs and %zu bytes of workspace; got %d, %zu\n", (size_t)WS_END, n_in, ws_size); grid = -1; return; }
        int dev = 0, cus = 0, per_cu = 0;
        hipGetDevice(&dev); hipDeviceGetAttribute(&cus, hipDeviceAttributeMultiprocessorCount, dev);
        if (hipFuncSetAttribute((const void*)mk_fwd, hipFuncAttributeMaxDynamicSharedMemorySize, LDS_BYTES) != hipSuccess) { fprintf(stderr, "kernel_launch: hipFuncSetAttribute failed\n"); grid = -1; return; }
        if (hipOccupancyMaxActiveBlocksPerMultiprocessor(&per_cu, (const void*)mk_fwd, 512, LDS_BYTES) != hipSuccess || per_cu < 1) { fprintf(stderr, "kernel_launch: occupancy query says %d\n", per_cu); per_cu = 1; }
        (void)hipGetLastError();
        grid = cus;
    }
    if (grid < 0) return;
    if (hipMemsetAsync((char*)d_ws + WS_BAR, 0, WS_BAR_BYTES, stream) != hipSuccess) { fprintf(stderr, "kernel_launch: memset of the barrier words failed\n"); return; }
    Args a{};
    for (int i = 0; i < 33; ++i) a.in[i] = (const float*)d_in[i];
    a.out = (float*)d_out; a.ws = (unsigned char*)d_ws;
#if MK_PER_PHASE
    for (int ph = 0; ph < NPH; ++ph) { a.ph_lo = ph; a.ph_hi = ph + 1; hipLaunchKernelGGL(mk_fwd, dim3(grid), dim3(512), LDS_BYTES, stream, a); }
#else
    a.ph_lo = 0; a.ph_hi = NPH;
    void* args[] = {&a};
    hipError_t e = hipLaunchCooperativeKernel((const void*)mk_fwd, dim3(grid), dim3(512), args, LDS_BYTES, stream);
    if (e != hipSuccess) fprintf(stderr, "cooperative launch failed: %s (grid %d)\n", hipGetErrorString(e), grid);
#endif
}
```

```cpp
#include <hip/hip_runtime.h>
#include <hip/hip_cooperative_groups.h>
#include <cstdio>
namespace cg = cooperative_groups;

#ifndef PH_MASK
#define PH_MASK 0x7FFFF
#endif
#ifndef REP_MASK
#define REP_MASK 0x0
#endif
#ifndef MK_PER_PHASE
#define MK_PER_PHASE 0
#endif

#define LAS __attribute__((address_space(3)))
typedef unsigned short bf16_t;
typedef short bf16x8 __attribute__((ext_vector_type(8)));
typedef float f32x4 __attribute__((ext_vector_type(4)));
typedef float f32x2 __attribute__((ext_vector_type(2)));
typedef unsigned u32x4 __attribute__((ext_vector_type(4)));
typedef unsigned u32x2 __attribute__((ext_vector_type(2)));

constexpr int D = 1024, DFF = 2816, NCTX = 16 * 256, NLAT = 8 * 4096, TROWS = NCTX + NLAT;
constexpr int NCHUNK = TROWS / 128;
constexpr int LDS_BYTES = 135168 + 16;
constexpr int NPH = 19;

constexpr size_t al256(size_t x) { return (x + 255) & ~(size_t)255; }
constexpr size_t WS_BAR = 0;
constexpr size_t WS_BAR_BYTES = 3456 * 4;
constexpr size_t WS_MOD = al256(WS_BAR + WS_BAR_BYTES);
constexpr size_t WS_PE = al256(WS_MOD + 2 * 9 * 6144 * 4);
constexpr size_t WS_RSTD = al256(WS_PE + 64 * 512 * 4);
constexpr size_t WS_AGG = al256(WS_RSTD + (size_t)TROWS * 4);
constexpr size_t WS_CAR = al256(WS_AGG + (size_t)2 * 2 * NCHUNK * 1024 * 4);
constexpr size_t WS_WIN0 = al256(WS_CAR + (size_t)2 * NCHUNK * 1024 * 4);
constexpr size_t WS_WOUT0 = WS_WIN0 + (size_t)2048 * 1024 * 2;
constexpr size_t WS_FIN0 = WS_WOUT0 + (size_t)1024 * 1024 * 2;
constexpr size_t WS_FOUT0 = WS_FIN0 + (size_t)5632 * 1024 * 2;
constexpr size_t WS_FIN1 = WS_FOUT0 + (size_t)1024 * 2816 * 2;
constexpr size_t WS_FOUT1 = WS_FIN1 + (size_t)5632 * 1024 * 2;
constexpr size_t WS_POOLW = WS_FOUT1 + (size_t)1024 * 2816 * 2;
constexpr size_t WS_WG = WS_POOLW + (size_t)1024 * 256 * 2;
constexpr size_t MIB = 1024 * 1024;
constexpr size_t WS_BASE = al256(WS_WG + (size_t)16 * 256 * 256 * 2);
constexpr size_t WS_H = WS_BASE;
constexpr size_t WS_Y = WS_BASE + 72 * MIB;
constexpr size_t WS_Y1 = WS_BASE + 144 * MIB;
constexpr size_t WS_B = WS_BASE + 216 * MIB;
constexpr size_t WS_DBF = WS_BASE;
constexpr size_t WS_DBB = WS_BASE + 144 * MIB;
constexpr size_t WS_GACT = WS_BASE + 288 * MIB;
constexpr size_t WS_REC = WS_BASE + 360 * MIB;
constexpr size_t WS_END = WS_BASE + 432 * MIB;

struct Args { const float* in[33]; float* out; unsigned char* ws; int ph_lo, ph_hi; };

__device__ __forceinline__ unsigned cvt_pk_bf16(float lo, float hi) { unsigned r; asm volatile("v_cvt_pk_bf16_f32 %0, %1, %2" : "=v"(r) : "v"(lo), "v"(hi)); return r; }
__device__ __forceinline__ float bf_lo(unsigned w) { return __uint_as_float(w << 16); }
__device__ __forceinline__ float bf_hi(unsigned w) { return __uint_as_float(w & 0xffff0000u); }
__device__ __forceinline__ float sigmoid_f(float x) { return __builtin_amdgcn_rcpf(1.0f + __builtin_amdgcn_exp2f(-1.44269504089f * x)); }
__device__ __forceinline__ float silu_f(float x) { return x * sigmoid_f(x); }
__device__ __forceinline__ float gelu_tanh_f(float x) { const float z = x + 0.044715f * x * x * x; return x * __builtin_amdgcn_rcpf(1.0f + __builtin_amdgcn_exp2f(-2.0f * 0.7978845608f * 1.44269504089f * z)); }
__device__ __forceinline__ float xchg16(float x, bool oddrow) { const u32x2 r = __builtin_amdgcn_permlane16_swap(__float_as_uint(x), __float_as_uint(x), false, false); return __uint_as_float(oddrow ? r.x : r.y); }
__device__ __forceinline__ float xchg32(float x, bool upper) { const u32x2 r = __builtin_amdgcn_permlane32_swap(__float_as_uint(x), __float_as_uint(x), false, false); return __uint_as_float(upper ? r.x : r.y); }
__device__ __forceinline__ float wave_sum(float v) {
#pragma unroll
    for (int o = 32; o >= 1; o >>= 1) v += __shfl_xor(v, o);
    return v;
}

#define XB_TMO      128
#define XB_XCNT(j)  (256  + 64 * (j))
#define XB_XSUB(j)  (1280 + 64 * (j))
#define XB_XGEN(j)  (2304 + 64 * (j))
#define XB_TOP      3328
#define XB_TOPGEN   3392
#define XCD_BAR_WORDS 3456
#define XB_SPIN_CAP (1u << 22)
__device__ __forceinline__ unsigned xb_ld(unsigned* p)              { return __hip_atomic_load(p, __ATOMIC_RELAXED, __HIP_MEMORY_SCOPE_AGENT); }
__device__ __forceinline__ unsigned xb_add(unsigned* p, unsigned v) { return __hip_atomic_fetch_add(p, v, __ATOMIC_RELAXED, __HIP_MEMORY_SCOPE_AGENT); }
__device__ __forceinline__ unsigned xb_xcc_id() { return (unsigned)__builtin_amdgcn_s_getreg((3 << 11) | 20) & 0xFu; }
#define XB_SPIN(cond, bar) do { unsigned _sp = 0; while (cond) { __builtin_amdgcn_s_sleep(1); \
    if ((++_sp & 255u) == 0u) { if (xb_ld(&(bar)[XB_TMO])) break; if (_sp > XB_SPIN_CAP) { atomicAdd(&(bar)[XB_TMO], 1u); break; } } } } while (0)
struct XcdBarrier { unsigned* bar; unsigned x; volatile LAS unsigned* st; };
__device__ __forceinline__ XcdBarrier xcd_barrier_post(unsigned* bar, volatile LAS unsigned* st) {
    XcdBarrier b; b.bar = bar; b.x = xb_xcc_id(); b.st = st;
    if (threadIdx.x == 0) (void)xb_add(&bar[XB_XCNT(b.x)], 1u);
    return b;
}
__device__ __forceinline__ void xcd_barrier_complete(unsigned* bar, unsigned x, unsigned& nloc, unsigned& nx) {
    const unsigned G = gridDim.x * gridDim.y * gridDim.z;
    unsigned sum, cnt, mine, sp = 0u;
    for (;;) {
        sum = 0u; cnt = 0u; mine = 0u;
#pragma unroll
        for (unsigned j = 0; j < 16; ++j) { const unsigned c = xb_ld(&bar[XB_XCNT(j)]); sum += c; cnt += (c > 0u) ? 1u : 0u; mine = (j == x) ? c : mine; }
        if (sum == G) break;
        __builtin_amdgcn_s_sleep(1);
        if ((++sp & 255u) == 0u) { if (xb_ld(&bar[XB_TMO])) break; if (sp > XB_SPIN_CAP) { atomicAdd(&bar[XB_TMO], 1u); break; } }
    }
    nloc = mine > 0u ? mine : 1u; nx = cnt > 0u ? cnt : 1u;
}
__device__ __forceinline__ void xcd_barrier(const XcdBarrier& b) {
    asm volatile("s_waitcnt vmcnt(0)" ::: "memory");
    __syncthreads();
    if (threadIdx.x == 0) {
        unsigned* bar = b.bar;
        __builtin_amdgcn_s_waitcnt(0);
        unsigned nloc = b.st[0], nx = b.st[1];
        if (nloc == 0u) { xcd_barrier_complete(bar, b.x, nloc, nx); b.st[0] = nloc; b.st[1] = nx; }
        const unsigned old = xb_add(&bar[XB_XSUB(b.x)], 1u);
        const unsigned gen = old / nloc;
        if (old + 1u == (gen + 1u) * nloc) {
            __builtin_amdgcn_fence(__ATOMIC_RELEASE, "agent");
            asm volatile("s_waitcnt vmcnt(0)" ::: "memory");
            const unsigned og = xb_add(&bar[XB_TOP], 1u);
            const unsigned tg = og / nx;
            if (og + 1u == (tg + 1u) * nx) xb_add(&bar[XB_TOPGEN], 1u);
            else XB_SPIN(xb_ld(&bar[XB_TOPGEN]) == tg, bar);
            __builtin_amdgcn_fence(__ATOMIC_ACQUIRE, "agent");
            xb_add(&bar[XB_XGEN(b.x)], 1u);
            asm volatile("s_waitcnt vmcnt(0)" ::: "memory");
        } else {
            XB_SPIN(xb_ld(&bar[XB_XGEN(b.x)]) == gen, bar);
            __builtin_amdgcn_fence(__ATOMIC_ACQUIRE, "agent");
            asm volatile("s_waitcnt vmcnt(0)" ::: "memory");
        }
    }
    __syncthreads();
}

namespace pg8 {
constexpr int BM = 256, BK = 64, HALF = 128, HTB = HALF * BK * 2, STAGE_BYTES = 8 * HTB, NXCD = 8, WGM = 8;
__host__ __device__ __forceinline__ int lds_byte(int r, int c) { const int st = (r >> 4) * 2 + (c >> 5), rr = r & 15, cc = c & 31, ob = rr * 64 + cc * 2; return st * 1024 + (ob ^ (((ob >> 9) & 1) << 5)); }
__host__ __device__ __forceinline__ void stage_rc(int b, int& R, int& C) { const int st = b / 1024, sb = b % 1024, swz = sb ^ (((sb >> 9) & 1) << 5); R = (st >> 1) * 16 + swz / 64; C = (st & 1) * 32 + (swz % 64) / 2; }
__host__ __device__ __forceinline__ int perm32(int rho) { const int n = rho >> 4, i = rho & 15; return 8 * (i >> 2) + 4 * n + (i & 3); }
struct Unit { int pm, pn, kt0, nkt; };
struct Gemm { const bf16_t* A; const bf16_t* Bt; int M, N, K, lda, diag; };
struct StaticOrder {
    int nM, nN, nwg, G, c, ntfull, tail, rev;
    __device__ __forceinline__ void init(int M, int N, int K, int G_, int c_, int tail_) { nM = M / BM; nN = N / BM; G = G_; c = c_; ntfull = K / BK; rev = tail_ >> 1; tail_ &= 1; tail = (tail_ && G_ == 256 && nM == 144 && nN == 4 && ntfull == 44) ? 1 : 0; if (tail) nM = 128; nwg = nM * nN; }
    __device__ __forceinline__ bool next(int i, Unit& u) const {
        if (tail && i == 2) { const int tile = c >> 2, ks = c & 3; u.pm = 128 + (tile >> 2); u.pn = tile & 3; u.kt0 = ks < 2 ? ks * 12 : 24 + (ks - 2) * 10; u.nkt = ks < 2 ? 12 : 10; return true; }
        long L = (long)i * G + c; if (L >= nwg) return false; if (rev) L = nwg - 1 - L;
        int wgid = (int)L; { const int q = nwg / NXCD, r = nwg % NXCD, xcd = wgid % NXCD, off = wgid / NXCD; wgid = (xcd < r ? xcd * (q + 1) : r * (q + 1) + (xcd - r) * q) + off; }
        const int nig = WGM * nN, gid = wgid / nig, fm = gid * WGM, gsz = (nM - fm) < WGM ? (nM - fm) : WGM;
        u.pm = fm + ((wgid % nig) % gsz); u.pn = (wgid % nig) / gsz; u.kt0 = 0; u.nkt = ntfull; return true;
    }
};
struct Epi {
    int mode;
    bf16_t* O0; bf16_t* O1; const float* pb; const float* ps; float* PART; int ntfull;
    __device__ __forceinline__ void operator()(const f32x4 (&acc)[2][2][4][2], const Unit& u, int wr, int wc, int fr, int fq) const {
        const int row0 = u.pm * BM + wr * 64 + fr;
        if (u.nkt != ntfull) {
            const int ks = u.kt0 == 0 ? 0 : (u.kt0 == 12 ? 1 : (u.kt0 == 24 ? 2 : 3)), tile = (u.pm - 128) * 4 + u.pn;
            bf16_t* dst = (bf16_t*)PART + (size_t)(ks * 64 + tile) * 65536 + (size_t)(wr * 64 + fr) * 256 + wc * 32 + 8 * fq;
#pragma unroll
            for (int ai = 0; ai < 2; ++ai)
#pragma unroll
                for (int m = 0; m < 4; ++m)
#pragma unroll
                    for (int bj = 0; bj < 2; ++bj) { const f32x4 v0 = acc[ai][bj][m][0], v1 = acc[ai][bj][m][1];
                        u32x4 w; w.x = cvt_pk_bf16(v0[0], v0[1]); w.y = cvt_pk_bf16(v0[2], v0[3]); w.z = cvt_pk_bf16(v1[0], v1[1]); w.w = cvt_pk_bf16(v1[2], v1[3]);
                        *(u32x4*)(dst + (size_t)(ai * HALF + m * 16) * 256 + bj * HALF) = w; }
            return;
        }
        if (mode == 2) {
            const int col0 = u.pn * 128 + wc * 32 + 8 * fq;
#pragma unroll
            for (int ai = 0; ai < 2; ++ai)
#pragma unroll
                for (int m = 0; m < 4; ++m) {
                    bf16_t* rowp = O0 + (size_t)(row0 + ai * HALF + m * 16) * DFF + col0;
                    const f32x4 g0 = acc[ai][0][m][0], g1 = acc[ai][0][m][1], u0 = acc[ai][1][m][0], u1 = acc[ai][1][m][1];
                    u32x4 w;
#define SWG(gv, uv) (((gv) * (uv)) * __builtin_amdgcn_rcpf(1.0f + __builtin_amdgcn_exp2f(gv)))
                    w.x = cvt_pk_bf16(SWG(g0[0], u0[0]), SWG(g0[1], u0[1])); w.y = cvt_pk_bf16(SWG(g0[2], u0[2]), SWG(g0[3], u0[3]));
                    w.z = cvt_pk_bf16(SWG(g1[0], u1[0]), SWG(g1[1], u1[1])); w.w = cvt_pk_bf16(SWG(g1[2], u1[2]), SWG(g1[3], u1[3]));
#undef SWG
                    *(u32x4*)rowp = w;
                }
        } else {
            bf16_t* base = O0; int colt = u.pn * BM; bool act = false;
            if (mode == 0) { if (u.pn >= 4) { base = O1; colt -= 1024; } else act = true; }
            const int col0 = colt + wc * 32 + 8 * fq;
            f32x4 bv[2][2], sv[2][2];
#pragma unroll
            for (int bj = 0; bj < 2; ++bj)
#pragma unroll
                for (int n = 0; n < 2; ++n) {
                    if (mode == 3) { bv[bj][n] = *(const f32x4*)(pb + col0 + bj * HALF + 4 * n); sv[bj][n] = *(const f32x4*)(ps + col0 + bj * HALF + 4 * n); }
                    else { bv[bj][n] = (f32x4){0.f, 0.f, 0.f, 0.f}; sv[bj][n] = (f32x4){1.f, 1.f, 1.f, 1.f}; }
                }
#pragma unroll
            for (int ai = 0; ai < 2; ++ai)
#pragma unroll
                for (int m = 0; m < 4; ++m) {
                    bf16_t* rowp = base + (size_t)(row0 + ai * HALF + m * 16) * D + col0;
#pragma unroll
                    for (int bj = 0; bj < 2; ++bj) {
                        f32x4 v0 = (acc[ai][bj][m][0] + bv[bj][0]) * sv[bj][0], v1 = (acc[ai][bj][m][1] + bv[bj][1]) * sv[bj][1];
                        if (act) {
#pragma unroll
                            for (int j = 0; j < 4; ++j) { v0[j] = gelu_tanh_f(v0[j]); v1[j] = gelu_tanh_f(v1[j]); }
                        }
                        u32x4 w; w.x = cvt_pk_bf16(v0[0], v0[1]); w.y = cvt_pk_bf16(v0[2], v0[3]); w.z = cvt_pk_bf16(v1[0], v1[1]); w.w = cvt_pk_bf16(v1[2], v1[3]);
                        *(u32x4*)(rowp + bj * HALF) = w;
                    }
                }
        }
    }
};

__device__ __forceinline__ void gemm_phase(LAS unsigned char* lds, const Gemm g, const StaticOrder& S, const Epi& E) {
    const int tid = threadIdx.x, wid = __builtin_amdgcn_readfirstlane(tid >> 6), lane = tid & 63, wr = wid >> 2, wc = wid & 3, fr = lane & 15, fq = lane >> 4;
    const int K = g.K, lda = g.lda;
    unsigned voffA[2], voffB[2];
#pragma unroll
    for (int i = 0; i < 2; ++i) { int R, C; stage_rc(tid * 16 + i * 8192, R, C); const int Rb = (R & ~31) + perm32(R & 31);
        voffA[i] = (unsigned)(R * lda + C) * 2u; voffB[i] = (unsigned)(Rb * K + C) * 2u; }
    const size_t kstep = (size_t)(BK * 2);
    const size_t hstepA = (size_t)HALF * lda * 2, hstepB = (size_t)HALF * K * 2;
    const size_t tstepA = 2 * hstepA, tstepB = 2 * hstepB;
    const size_t dstep = g.diag ? (size_t)K * 2 : 0;
    const unsigned ldsw = (unsigned)wid * 1024u;
    const int aoff = lds_byte(wr * 64 + fr, fq * 8), boff = lds_byte(wc * 32 + fr, fq * 8);
#define PG8_SA(b, h) (((b) * 2 + (h)) * HTB)
#define PG8_SB(b, h) ((4 + (b) * 2 + (h)) * HTB)
#define PG8_STAGE(bufoff, gbase, voff) do { _Pragma("unroll") for (int _i = 0; _i < 2; ++_i) \
        __builtin_amdgcn_global_load_lds((const unsigned*)((const char*)(gbase) + (voff)[_i]), (LAS unsigned*)(lds + (bufoff) + ldsw + _i * 8192), 16, 0, 0); } while (0)
#define PG8_LDA(dst, b, h) do { _Pragma("unroll") for (int m = 0; m < 4; ++m) _Pragma("unroll") for (int k = 0; k < 2; ++k) dst[m][k] = *(const LAS bf16x8*)(lds + PG8_SA(b, h) + aoff + m * 2048 + k * 1024); } while (0)
#define PG8_LDB(dst, b, h) do { _Pragma("unroll") for (int n = 0; n < 2; ++n) _Pragma("unroll") for (int k = 0; k < 2; ++k) dst[n][k] = *(const LAS bf16x8*)(lds + PG8_SB(b, h) + boff + n * 2048 + k * 1024); } while (0)
#define PG8_MMA(ai, bj, At, Bt) do { __builtin_amdgcn_s_setprio(1); _Pragma("unroll") for (int m = 0; m < 4; ++m) _Pragma("unroll") for (int n = 0; n < 2; ++n) _Pragma("unroll") for (int k = 0; k < 2; ++k) \
        acc[ai][bj][m][n] = __builtin_amdgcn_mfma_f32_16x16x32_bf16(Bt[n][k], At[m][k], acc[ai][bj][m][n], 0, 0, 0); __builtin_amdgcn_s_setprio(0); } while (0)
#define PG8_WAIT_V(n) asm volatile("s_waitcnt vmcnt(" #n ")" ::: "memory")
#define PG8_WAIT_L(n) asm volatile("s_waitcnt lgkmcnt(" #n ")" ::: "memory")
#define PG8_BAR __builtin_amdgcn_s_barrier()
#define PG8_SCHED __builtin_amdgcn_sched_barrier(0)
    Unit cur, nxt; int ui = 0;
    if (!S.next(0, cur)) return;
    f32x4 acc[2][2][4][2];
#pragma unroll
    for (int a = 0; a < 2; ++a)
#pragma unroll
        for (int b = 0; b < 2; ++b)
#pragma unroll
            for (int m = 0; m < 4; ++m)
#pragma unroll
                for (int n = 0; n < 2; ++n) acc[a][b][m][n] = (f32x4){0.f, 0.f, 0.f, 0.f};
    bf16x8 At[4][2], B0[2][2], B1[2][2];
    const char* cA = (const char*)g.A + (size_t)cur.pm * tstepA + (size_t)cur.pn * dstep + (size_t)cur.kt0 * kstep; const char* cB = (const char*)g.Bt + (size_t)cur.pn * tstepB + (size_t)cur.kt0 * kstep;
    PG8_STAGE(PG8_SB(0, 0), cB, voffB); PG8_STAGE(PG8_SB(0, 1), cB + hstepB, voffB); PG8_STAGE(PG8_SA(0, 0), cA, voffA); PG8_STAGE(PG8_SA(0, 1), cA + hstepA, voffA);
    if (wr == 1) PG8_BAR;
    PG8_WAIT_V(2); PG8_BAR;
    PG8_STAGE(PG8_SB(1, 0), cB + kstep, voffB); PG8_STAGE(PG8_SA(1, 0), cA + kstep, voffA); PG8_STAGE(PG8_SB(1, 1), cB + hstepB + kstep, voffB);
    PG8_WAIT_V(6); PG8_BAR;
    for (;;) {
        const bool has_next = S.next(ui + 1, nxt);
        const char* nA = has_next ? (const char*)g.A + (size_t)nxt.pm * tstepA + (size_t)nxt.pn * dstep + (size_t)nxt.kt0 * kstep : cA; const char* nB = has_next ? (const char*)g.Bt + (size_t)nxt.pn * tstepB + (size_t)nxt.kt0 * kstep : cB;
        const int nt = cur.nkt;
        for (int t = 0; t < nt; t += 2) {
            const bool last = (t == nt - 2);
            const char* a1 = cA + (size_t)(t + 1) * kstep;
            const char* a2 = last ? nA : cA + (size_t)(t + 2) * kstep; const char* b2 = last ? nB : cB + (size_t)(t + 2) * kstep;
            const char* a3 = a2 + kstep; const char* b3 = b2 + kstep;
            PG8_LDB(B0, 0, 0); PG8_LDB(B1, 0, 1); PG8_SCHED; PG8_LDA(At, 0, 0); PG8_STAGE(PG8_SA(1, 1), a1 + hstepA, voffA);
            PG8_WAIT_V(8); PG8_WAIT_L(0); PG8_BAR; PG8_MMA(0, 0, At, B0); PG8_MMA(0, 1, At, B1); PG8_BAR; PG8_SCHED;
            PG8_LDA(At, 0, 1); PG8_STAGE(PG8_SB(0, 0), b2, voffB); PG8_STAGE(PG8_SB(0, 1), b2 + hstepB, voffB); PG8_STAGE(PG8_SA(0, 0), a2, voffA);
            PG8_WAIT_V(8); PG8_WAIT_L(0); PG8_BAR; PG8_MMA(1, 0, At, B0); PG8_MMA(1, 1, At, B1); PG8_BAR; PG8_SCHED;
            PG8_LDB(B0, 1, 0); PG8_LDB(B1, 1, 1); PG8_SCHED; PG8_LDA(At, 1, 0); PG8_STAGE(PG8_SA(0, 1), a2 + hstepA, voffA);
            PG8_WAIT_V(8); PG8_WAIT_L(0); PG8_BAR; PG8_MMA(0, 0, At, B0); PG8_MMA(0, 1, At, B1); PG8_BAR; PG8_SCHED;
            PG8_LDA(At, 1, 1); PG8_STAGE(PG8_SB(1, 0), b3, voffB); PG8_STAGE(PG8_SB(1, 1), b3 + hstepB, voffB); PG8_STAGE(PG8_SA(1, 0), a3, voffA);
            PG8_WAIT_V(8); PG8_WAIT_L(0); PG8_BAR; PG8_MMA(1, 0, At, B0); PG8_MMA(1, 1, At, B1); PG8_BAR; PG8_SCHED;
        }
        if (wr == 0) PG8_BAR;
        E(acc, cur, wr, wc, fr, fq);
        if (!has_next) break;
#pragma unroll
        for (int a = 0; a < 2; ++a)
#pragma unroll
            for (int b = 0; b < 2; ++b)
#pragma unroll
                for (int m = 0; m < 4; ++m)
#pragma unroll
                    for (int n = 0; n < 2; ++n) acc[a][b][m][n] = (f32x4){0.f, 0.f, 0.f, 0.f};
        cur = nxt; cA = nA; cB = nB; ++ui;
        if (wr == 1) PG8_BAR;
    }
    PG8_WAIT_V(0);
    PG8_BAR;
#undef PG8_SA
#undef PG8_SB
#undef PG8_STAGE
#undef PG8_LDA
#undef PG8_LDB
#undef PG8_MMA
#undef PG8_WAIT_V
#undef PG8_WAIT_L
#undef PG8_BAR
#undef PG8_SCHED
}
}

__device__ __forceinline__ void tail_reduce(const float* PART, bf16_t* Y) {
    for (int id = blockIdx.x * 512 + threadIdx.x; id < 64 * 8192; id += gridDim.x * 512) {
        const int tile = id >> 13, rem = id & 8191, r = rem >> 5, c8 = (rem & 31) * 8;
        f32x4 s0 = (f32x4){0.f, 0.f, 0.f, 0.f}, s1 = s0;
#pragma unroll
        for (int ks = 0; ks < 4; ++ks) { const u32x4 p = *(const u32x4*)((const bf16_t*)PART + (size_t)(ks * 64 + tile) * 65536 + (size_t)r * 256 + c8);
            s0 += (f32x4){bf_lo(p.x), bf_hi(p.x), bf_lo(p.y), bf_hi(p.y)}; s1 += (f32x4){bf_lo(p.z), bf_hi(p.z), bf_lo(p.w), bf_hi(p.w)}; }
        u32x4 w; w.x = cvt_pk_bf16(s0[0], s0[1]); w.y = cvt_pk_bf16(s0[2], s0[3]); w.z = cvt_pk_bf16(s1[0], s1[1]); w.w = cvt_pk_bf16(s1[2], s1[3]);
        *(u32x4*)(Y + (size_t)(32768 + (tile >> 2) * 256 + r) * 1024 + (tile & 3) * 256 + c8) = w;
    }
}

__device__ __forceinline__ void conv_tile(LAS float* tile, const float* src, int ldsrc, int k0, int c0, bf16_t* dst, int ldd, int n0, int kd0, float scale = 1.0f) {
    const int tid = threadIdx.x;
#pragma unroll
    for (int i = 0; i < 2; ++i) { const int e = tid + i * 512, r = e >> 4, c4 = e & 15;
        const f32x4 v = __builtin_nontemporal_load((const f32x4*)(src + (size_t)(k0 + r) * ldsrc + c0 + c4 * 4));
        tile[r * 65 + c4 * 4 + 0] = v[0]; tile[r * 65 + c4 * 4 + 1] = v[1]; tile[r * 65 + c4 * 4 + 2] = v[2]; tile[r * 65 + c4 * 4 + 3] = v[3]; }
    __syncthreads();
    { const int kg = tid & 7, n = tid >> 3; float f[8];
#pragma unroll
      for (int j = 0; j < 8; ++j) f[j] = tile[(kg * 8 + j) * 65 + n] * scale;
      u32x4 w; w.x = cvt_pk_bf16(f[0], f[1]); w.y = cvt_pk_bf16(f[2], f[3]); w.z = cvt_pk_bf16(f[4], f[5]); w.w = cvt_pk_bf16(f[6], f[7]);
      *(u32x4*)(dst + (size_t)(n0 + n) * ldd + kd0 + kg * 8) = w; }
    __syncthreads();
}

__device__ __forceinline__ void phase_prologue(const Args& a, LAS unsigned char* lds) {
    const int tid = threadIdx.x, bid = blockIdx.x, G = gridDim.x;
    unsigned char* ws = a.ws;
    {
        LAS float* s = (LAS float*)lds;
        LAS float* red = (LAS float*)(lds + 9 * 1024 * 4);
        for (int i = tid; i < 9 * 1024; i += 512) { const int r = i >> 10, k = i & 1023; const float v = (r == 0) ? a.in[4][k] : a.in[3][(r - 1) * 1024 + k]; s[i] = silu_f(v); }
        __syncthreads();
        for (int slab = bid; slab < 256; slab += G) {
            const int l = slab >> 7, n0 = (slab & 127) * 48;
            const float* W = a.in[l ? 22 : 5]; const float* bias = a.in[l ? 23 : 6];
            const int kk = tid / 12, n4 = tid % 12;
            float acc[9][4];
#pragma unroll
            for (int r = 0; r < 9; ++r)
#pragma unroll
                for (int j = 0; j < 4; ++j) acc[r][j] = 0.f;
            if (kk < 42) {
#pragma unroll 5
                for (int i = 0; i < 25; ++i) { const int k = kk + 42 * i;
                    if (k < 1024) { const f32x4 w = __builtin_nontemporal_load((const f32x4*)(W + (size_t)k * 6144 + n0 + n4 * 4));
#pragma unroll
                        for (int r = 0; r < 9; ++r) { const float sv = s[r * 1024 + k];
#pragma unroll
                            for (int j = 0; j < 4; ++j) acc[r][j] += sv * w[j]; } } }
#pragma unroll
                for (int r = 0; r < 9; ++r)
#pragma unroll
                    for (int j = 0; j < 4; ++j) red[(kk * 9 + r) * 48 + n4 * 4 + j] = acc[r][j];
            }
            __syncthreads();
            if (tid < 432) { const int r = tid / 48, n = tid % 48; float t = 0.f;
                for (int k2 = 0; k2 < 42; ++k2) t += red[(k2 * 9 + r) * 48 + n];
                ((float*)(ws + WS_MOD))[(size_t)(l * 9 + r) * 6144 + n0 + n] = t + bias[n0 + n]; }
            __syncthreads();
        }
    }
    for (int i = bid * 512 + tid; i < 64 * 512; i += G * 512) { const int p = i >> 9, j = i & 255; const float om = 1.0f / powf(10000.0f, (float)j * (1.0f / 256.0f)); const float ang = (float)p * om;
        ((float*)(ws + WS_PE))[i] = (i & 256) ? cosf(ang) : sinf(ang); }
    {
        LAS float* tile = (LAS float*)lds;
        constexpr int T0 = 512, T1 = T0 + 256, T2 = T1 + 1408, T3 = T2 + 704, T4 = T3 + 1408, T5 = T4 + 704, T6 = T5 + 64, T7 = T6 + 256;
        for (int t = bid; t < T7; t += G) {
            if (t < T0) { const int kt = t & 15, ntl = t >> 4; conv_tile(tile, a.in[9], 2048, kt * 64, ntl * 64, (bf16_t*)(ws + WS_WIN0), 1024, ntl * 64, kt * 64); }
            else if (t < T1) { const int u = t - T0, kt = u & 15, ntl = u >> 4; conv_tile(tile, a.in[17], 1024, kt * 64, ntl * 64, (bf16_t*)(ws + WS_WOUT0), 1024, ntl * 64, kt * 64); }
            else if (t < T2 || (t >= T3 && t < T4)) { const bool l1 = t >= T3; const int u = t - (l1 ? T3 : T1), kt = u & 15, ntl = u >> 4;
                const int n0 = ntl * 64, pn = n0 >> 8, bj = (n0 & 255) >> 7, j0 = n0 & 127, c0 = bj * DFF + pn * 128 + j0;
                conv_tile(tile, a.in[l1 ? 31 : 20], 2 * DFF, kt * 64, c0, (bf16_t*)(ws + (l1 ? WS_FIN1 : WS_FIN0)), 1024, n0, kt * 64, bj ? -0.69314718056f : -1.44269504089f); }
            else if (t < T3 || (t >= T4 && t < T5)) { const bool l1 = t >= T4; const int u = t - (l1 ? T4 : T2), kt = u % 44, ntl = u / 44;
                conv_tile(tile, a.in[l1 ? 32 : 21], 1024, kt * 64, ntl * 64, (bf16_t*)(ws + (l1 ? WS_FOUT1 : WS_FOUT0)), DFF, ntl * 64, kt * 64); }
            else if (t < T6) { const int u = t - T5, g = u >> 4, kt = u & 3, ntl = (u >> 2) & 3;
                conv_tile(tile, a.in[26] + (size_t)g * 65536, 256, kt * 64, ntl * 64, (bf16_t*)(ws + WS_POOLW), 256, g * 256 + ntl * 64, kt * 64); }
            else { const int u = t - T6, mtx = u >> 4, kt = u & 3, ntl = (u >> 2) & 3;
                const int dir = mtx >> 3, gate = (mtx >> 2) & 1, blk = mtx & 3;
                conv_tile(tile, a.in[gate ? 14 : 12] + (size_t)(dir * 4 + blk) * 65536, 256, kt * 64, ntl * 64, (bf16_t*)(ws + WS_WG) + (size_t)mtx * 65536, 256, ntl * 64, kt * 64, -1.44269504089f); }
        }
    }
}

template <int MODE>
__device__ __forceinline__ void rows_load(const float* xsrc, const bf16_t* Y, const float* PE, int row, int lane, f32x4 (&x)[4], u32x2 (&yw)[4], f32x4 (&pe)[4]) {
#pragma unroll
    for (int i = 0; i < 4; ++i) x[i] = (MODE == 0) ? __builtin_nontemporal_load((const f32x4*)(xsrc + (size_t)row * D + 4 * lane + 256 * i)) : *(const f32x4*)(xsrc + (size_t)row * D + 4 * lane + 256 * i);
    if (MODE == 0 || MODE == 4) { const int t = (row - NCTX) & 4095, pr = t >> 6, pc = t & 63;
#pragma unroll
        for (int i = 0; i < 4; ++i) { const int c = 4 * lane + 256 * i; pe[i] = *(const f32x4*)(PE + (size_t)((i < 2) ? pr : pc) * 512 + (c & 511)); }
    }
    if (MODE != 0) {
#pragma unroll
        for (int i = 0; i < 4; ++i) yw[i] = *(const u32x2*)(Y + (size_t)row * D + 4 * lane + 256 * i);
    }
}
template <int MODE>
__device__ __forceinline__ void rows_process(float* X, bf16_t* H, float* RSTD, int row, int lane, float pes, f32x4 (&x)[4], const u32x2 (&yw)[4], const f32x4 (&pe)[4],
                                             const f32x4 (&gp)[4], const f32x4 (&Gm)[4], const f32x4 (&Sm)[4]) {
    if (MODE == 0 || MODE == 4) {
#pragma unroll
        for (int i = 0; i < 4; ++i) x[i] = x[i] + pe[i] * pes;
    }
    if (MODE != 0) {
        float ss = 0.f; f32x4 y[4];
#pragma unroll
        for (int i = 0; i < 4; ++i) { y[i] = (f32x4){bf_lo(yw[i].x), bf_hi(yw[i].x), bf_lo(yw[i].y), bf_hi(yw[i].y)}; ss += (y[i][0] * y[i][0] + y[i][1] * y[i][1]) + (y[i][2] * y[i][2] + y[i][3] * y[i][3]); }
        ss = wave_sum(ss); const float ry = rsqrtf(ss * (1.0f / 1024.0f) + 1e-6f);
#pragma unroll
        for (int i = 0; i < 4; ++i) x[i] = x[i] + gp[i] * (y[i] * ry);
#pragma unroll
        for (int i = 0; i < 4; ++i) *(f32x4*)(X + (size_t)row * D + 4 * lane + 256 * i) = x[i];
    }
    if (MODE != 3) {
        float ss = 0.f;
#pragma unroll
        for (int i = 0; i < 4; ++i) ss += (x[i][0] * x[i][0] + x[i][1] * x[i][1]) + (x[i][2] * x[i][2] + x[i][3] * x[i][3]);
        ss = wave_sum(ss); const float rx = rsqrtf(ss * (1.0f / 1024.0f) + 1e-6f);
        if (MODE == 2) { if (lane == 0) RSTD[row] = rx; }
        else {
#pragma unroll
            for (int i = 0; i < 4; ++i) { const f32x4 h = (x[i] * rx) * Gm[i] + Sm[i]; u32x2 w; w.x = cvt_pk_bf16(h[0], h[1]); w.y = cvt_pk_bf16(h[2], h[3]);
                *(u32x2*)(H + (size_t)row * D + 4 * lane + 256 * i) = w; }
        }
    }
}
template <int MODE>
__device__ __forceinline__ void phase_rows(const Args& a, const float* modL_res  , int gate_idx, const float* post_g,
                           const float* modL_pre, int sh_idx, int sc_idx, const float* pre_g) {
    const int tid = threadIdx.x, lane = tid & 63, wid = tid >> 6;
    const int gw = blockIdx.x * 8 + wid, nw = gridDim.x * 8;
    float* X = a.out; bf16_t* H = (bf16_t*)(a.ws + WS_H); float* RSTD = (float*)(a.ws + WS_RSTD);
    const bf16_t* Y = (const bf16_t*)(a.ws + WS_Y); const float* PE = (const float*)(a.ws + WS_PE);
    const int rows_per = (TROWS + nw - 1) / nw;
    const int r_lo = gw * rows_per, r_hi = (r_lo + rows_per < TROWS) ? r_lo + rows_per : TROWS;
    int row = r_lo;
    while (row < r_hi) {
        const int cr = (row < NCTX) ? 0 : 1 + ((row - NCTX) >> 12);
        int seg_end = (cr == 0) ? NCTX : NCTX + cr * 4096; if (seg_end > r_hi) seg_end = r_hi;
        const float* xsrc = (MODE == 0 || MODE == 4) ? ((cr == 0) ? a.in[0] : a.in[1] - (size_t)NCTX * D) : (const float*)X;
        const float pes = (cr == 0) ? 0.f : 1.f;
        f32x4 gp[4], Gm[4], Sm[4];
#pragma unroll
        for (int i = 0; i < 4; ++i) { const int c = 4 * lane + 256 * i; gp[i] = (f32x4){0.f, 0.f, 0.f, 0.f}; Gm[i] = gp[i]; Sm[i] = gp[i];
            if (MODE != 0) { gp[i] = *(const f32x4*)(modL_res + (size_t)cr * 6144 + gate_idx * 1024 + c) * *(const f32x4*)(post_g + c); }
            if (MODE == 0 || MODE == 1 || MODE == 4) { Gm[i] = (*(const f32x4*)(modL_pre + (size_t)cr * 6144 + sc_idx * 1024 + c) + 1.0f) * *(const f32x4*)(pre_g + c); Sm[i] = *(const f32x4*)(modL_pre + (size_t)cr * 6144 + sh_idx * 1024 + c); } }
        f32x4 xa[4], xb[4], pa[4], pb[4]; u32x2 ya[4], yb[4];
#pragma unroll
        for (int i = 0; i < 4; ++i) { pa[i] = (f32x4){0.f, 0.f, 0.f, 0.f}; pb[i] = pa[i]; ya[i] = (u32x2){0u, 0u}; yb[i] = ya[i]; }
        rows_load<MODE>(xsrc, Y, PE, row, lane, xa, ya, pa);
        for (; row + 1 < seg_end; row += 2) {
            rows_load<MODE>(xsrc, Y, PE, row + 1, lane, xb, yb, pb);
            rows_process<MODE>(X, H, RSTD, row, lane, pes, xa, ya, pa, gp, Gm, Sm);
            rows_load<MODE>(xsrc, Y, PE, (row + 2 < seg_end) ? row + 2 : row + 1, lane, xa, ya, pa);
            rows_process<MODE>(X, H, RSTD, row + 1, lane, pes, xb, yb, pb, gp, Gm, Sm);
        }
        if (row < seg_end) { rows_process<MODE>(X, H, RSTD, row, lane, pes, xa, ya, pa, gp, Gm, Sm); ++row; }
    }
}

template <bool SRC_IN, bool HAS_Y2>
__device__ __forceinline__ void rows2_load(const float* xsrc, const bf16_t* Y1, const bf16_t* Y2, const float* PE, int row, int lane, f32x4 (&x)[4], u32x2 (&y1)[4], u32x2 (&y2)[4], f32x4 (&pe)[4]) {
#pragma unroll
    for (int i = 0; i < 4; ++i) x[i] = SRC_IN ? __builtin_nontemporal_load((const f32x4*)(xsrc + (size_t)row * D + 4 * lane + 256 * i)) : *(const f32x4*)(xsrc + (size_t)row * D + 4 * lane + 256 * i);
    if (SRC_IN) { const int t = (row - NCTX) & 4095, pr = t >> 6, pc = t & 63;
#pragma unroll
        for (int i = 0; i < 4; ++i) { const int c = 4 * lane + 256 * i; pe[i] = *(const f32x4*)(PE + (size_t)((i < 2) ? pr : pc) * 512 + (c & 511)); }
    }
#pragma unroll
    for (int i = 0; i < 4; ++i) y1[i] = *(const u32x2*)(Y1 + (size_t)row * D + 4 * lane + 256 * i);
    if (HAS_Y2) {
#pragma unroll
        for (int i = 0; i < 4; ++i) y2[i] = __builtin_nontemporal_load((const u32x2*)(Y2 + (size_t)row * D + 4 * lane + 256 * i));
    }
}
__device__ __forceinline__ void rows2_addbranch(f32x4 (&x)[4], const u32x2 (&yw)[4], const f32x4 (&gp)[4]) {
    float ss = 0.f; f32x4 y[4];
#pragma unroll
    for (int i = 0; i < 4; ++i) { y[i] = (f32x4){bf_lo(yw[i].x), bf_hi(yw[i].x), bf_lo(yw[i].y), bf_hi(yw[i].y)}; ss += (y[i][0] * y[i][0] + y[i][1] * y[i][1]) + (y[i][2] * y[i][2] + y[i][3] * y[i][3]); }
    ss = wave_sum(ss); const float ry = rsqrtf(ss * (1.0f / 1024.0f) + 1e-6f);
#pragma unroll
    for (int i = 0; i < 4; ++i) x[i] = x[i] + gp[i] * (y[i] * ry);
}
template <bool SRC_IN, bool HAS_Y2, int OUT>
__device__ __forceinline__ void rows2_process(float* X, bf16_t* H, float* RSTD, int row, int lane, float pes, f32x4 (&x)[4], const u32x2 (&y1)[4], const u32x2 (&y2)[4], const f32x4 (&pe)[4],
                                              const f32x4 (&gp1)[4], const f32x4 (&gp2)[4], const f32x4 (&Gm)[4], const f32x4 (&Sm)[4]) {
    if (SRC_IN) {
#pragma unroll
        for (int i = 0; i < 4; ++i) x[i] = x[i] + pe[i] * pes;
    }
    rows2_addbranch(x, y1, gp1);
    if (HAS_Y2) {
        rows2_addbranch(x, y2, gp2);
#pragma unroll
        for (int i = 0; i < 4; ++i) { if (OUT == 2) __builtin_nontemporal_store(x[i], (f32x4*)(X + (size_t)row * D + 4 * lane + 256 * i)); else *(f32x4*)(X + (size_t)row * D + 4 * lane + 256 * i) = x[i]; }
    }
    if (!HAS_Y2 || OUT == 1) {
        float ss = 0.f;
#pragma unroll
        for (int i = 0; i < 4; ++i) ss += (x[i][0] * x[i][0] + x[i][1] * x[i][1]) + (x[i][2] * x[i][2] + x[i][3] * x[i][3]);
        ss = wave_sum(ss); const float rx = rsqrtf(ss * (1.0f / 1024.0f) + 1e-6f);
        if (HAS_Y2) { if (lane == 0) RSTD[row] = rx; }
        else {
#pragma unroll
            for (int i = 0; i < 4; ++i) { const f32x4 h = (x[i] * rx) * Gm[i] + Sm[i]; u32x2 w; w.x = cvt_pk_bf16(h[0], h[1]); w.y = cvt_pk_bf16(h[2], h[3]);
                *(u32x2*)(H + (size_t)row * D + 4 * lane + 256 * i) = w; }
        }
    }
}
__device__ __forceinline__ void rows2_addbranch_f(f32x4 (&x)[4], const f32x4 (&y)[4], const f32x4 (&gp)[4]) {
    float ss = 0.f;
#pragma unroll
    for (int i = 0; i < 4; ++i) ss += (y[i][0] * y[i][0] + y[i][1] * y[i][1]) + (y[i][2] * y[i][2] + y[i][3] * y[i][3]);
    ss = wave_sum(ss); const float ry = rsqrtf(ss * (1.0f / 1024.0f) + 1e-6f);
#pragma unroll
    for (int i = 0; i < 4; ++i) x[i] = x[i] + gp[i] * (y[i] * ry);
}
template <bool SRC_IN, int OUT>
__device__ __forceinline__ void rows2_tailrow(const Args& a, const float* modL, const float* post1, const float* post2, int row, int lane) {
    float* X = a.out; float* RSTD = (float*)(a.ws + WS_RSTD);
    const bf16_t* Y1 = (const bf16_t*)(a.ws + WS_Y1); const bf16_t* PB = (const bf16_t*)(a.ws + WS_H); const float* PE = (const float*)(a.ws + WS_PE);
    const int cr = 1 + ((row - NCTX) >> 12);
    const float* xsrc = SRC_IN ? a.in[1] - (size_t)NCTX * D : (const float*)X;
    f32x4 x[4], pe[4], gp1[4], gp2[4], y2[4]; u32x2 y1[4], pw[4][4];
    const int t = (row - NCTX) & 4095, pr = t >> 6, pc = t & 63, pm = row >> 8, rr = row & 255;
#pragma unroll
    for (int i = 0; i < 4; ++i) { const int c = 4 * lane + 256 * i;
        x[i] = *(const f32x4*)(xsrc + (size_t)row * D + c);
        pe[i] = SRC_IN ? *(const f32x4*)(PE + (size_t)((i < 2) ? pr : pc) * 512 + (c & 511)) : (f32x4){0.f, 0.f, 0.f, 0.f};
        y1[i] = *(const u32x2*)(Y1 + (size_t)row * D + c);
#pragma unroll
        for (int ks = 0; ks < 4; ++ks) pw[i][ks] = *(const u32x2*)(PB + (size_t)(ks * 64 + (pm - 128) * 4 + i) * 65536 + (size_t)rr * 256 + 4 * lane);
        gp1[i] = *(const f32x4*)(modL + (size_t)cr * 6144 + 2 * 1024 + c) * *(const f32x4*)(post1 + c);
        gp2[i] = *(const f32x4*)(modL + (size_t)cr * 6144 + 5 * 1024 + c) * *(const f32x4*)(post2 + c); }
#pragma unroll
    for (int i = 0; i < 4; ++i) { y2[i] = (f32x4){0.f, 0.f, 0.f, 0.f};
#pragma unroll
        for (int ks = 0; ks < 4; ++ks) y2[i] += (f32x4){bf_lo(pw[i][ks].x), bf_hi(pw[i][ks].x), bf_lo(pw[i][ks].y), bf_hi(pw[i][ks].y)};
        x[i] = x[i] + pe[i]; }
    rows2_addbranch(x, y1, gp1);
    rows2_addbranch_f(x, y2, gp2);
#pragma unroll
    for (int i = 0; i < 4; ++i) { if (OUT == 2) __builtin_nontemporal_store(x[i], (f32x4*)(X + (size_t)row * D + 4 * lane + 256 * i)); else *(f32x4*)(X + (size_t)row * D + 4 * lane + 256 * i) = x[i]; }
    if (OUT == 1) { float ss = 0.f;
#pragma unroll
        for (int i = 0; i < 4; ++i) ss += (x[i][0] * x[i][0] + x[i][1] * x[i][1]) + (x[i][2] * x[i][2] + x[i][3] * x[i][3]);
        ss = wave_sum(ss); if (lane == 0) RSTD[row] = rsqrtf(ss * (1.0f / 1024.0f) + 1e-6f); }
}
template <bool SRC_IN, bool HAS_Y2, int OUT>
__device__ __forceinline__ void phase_rows2(const Args& a, const float* modL  , const float* post1, const float* post2, const float* pre_g) {
    const int tid = threadIdx.x, lane = tid & 63, wid = tid >> 6;
    const int gw = blockIdx.x * 8 + wid, nw = gridDim.x * 8;
    float* X = a.out; bf16_t* H = (bf16_t*)(a.ws + WS_H); float* RSTD = (float*)(a.ws + WS_RSTD);
    const bf16_t* Y1 = (const bf16_t*)(a.ws + WS_Y1); const bf16_t* Y2 = (const bf16_t*)(a.ws + WS_Y); const float* PE = (const float*)(a.ws + WS_PE);
    const bool tailp = HAS_Y2 && (gridDim.x == 256);
    const int rows_per = tailp ? 16 : (TROWS + nw - 1) / nw;
    const int r_end = tailp ? 32768 : TROWS;
    const int r_lo = gw * rows_per, r_hi = (r_lo + rows_per < r_end) ? r_lo + rows_per : r_end;
    if (tailp) { rows2_tailrow<SRC_IN, OUT>(a, modL, post1, post2, 32768 + 2 * gw, lane); rows2_tailrow<SRC_IN, OUT>(a, modL, post1, post2, 32768 + 2 * gw + 1, lane); }
    int row = r_lo;
    while (row < r_hi) {
        const int cr = (row < NCTX) ? 0 : 1 + ((row - NCTX) >> 12);
        int seg_end = (cr == 0) ? NCTX : NCTX + cr * 4096; if (seg_end > r_hi) seg_end = r_hi;
        const float* xsrc = SRC_IN ? ((cr == 0) ? a.in[0] : a.in[1] - (size_t)NCTX * D) : (const float*)X;
        const float pes = (cr == 0) ? 0.f : 1.f;
        f32x4 gp1[4], gp2[4], Gm[4], Sm[4];
#pragma unroll
        for (int i = 0; i < 4; ++i) { const int c = 4 * lane + 256 * i; gp2[i] = (f32x4){0.f, 0.f, 0.f, 0.f}; Gm[i] = gp2[i]; Sm[i] = gp2[i];
            gp1[i] = *(const f32x4*)(modL + (size_t)cr * 6144 + 2 * 1024 + c) * *(const f32x4*)(post1 + c);
            if (HAS_Y2) gp2[i] = *(const f32x4*)(modL + (size_t)cr * 6144 + 5 * 1024 + c) * *(const f32x4*)(post2 + c);
            else { Gm[i] = (*(const f32x4*)(modL + (size_t)cr * 6144 + 4 * 1024 + c) + 1.0f) * *(const f32x4*)(pre_g + c); Sm[i] = *(const f32x4*)(modL + (size_t)cr * 6144 + 3 * 1024 + c); } }
        f32x4 xa[4], xb[4], pa[4], pb[4]; u32x2 y1a[4], y1b[4], y2a[4], y2b[4];
#pragma unroll
        for (int i = 0; i < 4; ++i) { pa[i] = (f32x4){0.f, 0.f, 0.f, 0.f}; pb[i] = pa[i]; y2a[i] = (u32x2){0u, 0u}; y2b[i] = y2a[i]; }
        rows2_load<SRC_IN, HAS_Y2>(xsrc, Y1, Y2, PE, row, lane, xa, y1a, y2a, pa);
        for (; row + 1 < seg_end; row += 2) {
            rows2_load<SRC_IN, HAS_Y2>(xsrc, Y1, Y2, PE, row + 1, lane, xb, y1b, y2b, pb);
            rows2_process<SRC_IN, HAS_Y2, OUT>(X, H, RSTD, row, lane, pes, xa, y1a, y2a, pa, gp1, gp2, Gm, Sm);
            rows2_load<SRC_IN, HAS_Y2>(xsrc, Y1, Y2, PE, (row + 2 < seg_end) ? row + 2 : row + 1, lane, xa, y1a, y2a, pa);
            rows2_process<SRC_IN, HAS_Y2, OUT>(X, H, RSTD, row + 1, lane, pes, xb, y1b, y2b, pb, gp1, gp2, Gm, Sm);
        }
        if (row < seg_end) { rows2_process<SRC_IN, HAS_Y2, OUT>(X, H, RSTD, row, lane, pes, xa, y1a, y2a, pa, gp1, gp2, Gm, Sm); ++row; }
    }
}

constexpr int UROW = 528;
__device__ __forceinline__ void phase_scan(const Args& a, LAS unsigned char* lds) {
    const int tid = threadIdx.x, lane = tid & 63, wid = tid >> 6, q = lane >> 4, cl = lane & 15;
    const int hb = blockIdx.x & 7, cb = hb >> 1;
    const int ewave = (hb & 1) * 128 + wid * 16;
    const int ch = cb * 256 + ewave + cl;
    const bf16_t* REC = (const bf16_t*)(a.ws + WS_REC); const bf16_t* WG = (const bf16_t*)(a.ws + WS_WG);
    float* AGG = (float*)(a.ws + WS_AGG);
    float bA[2], bX[2], c8[2];
#pragma unroll
    for (int d = 0; d < 2; ++d) { bA[d] = -1.44269504089f * a.in[13][d * 1024 + ch]; bX[d] = -1.44269504089f * a.in[15][d * 1024 + ch];
        const float lam = a.in[16][d * 1024 + ch]; c8[d] = -8.0f * log1pf(expf(-lam)) * 1.44269504089f; }
    const int ch8 = tid & 31, rgrp = tid >> 5;
    const int loff = q * 4 * 1024 + ch;
    const int nblk = gridDim.x >> 3;
    for (int ck = blockIdx.x >> 3; ck < NCHUNK; ck += nblk) {
        int cis, nch, seqrow0;
        if (ck < 32) { cis = ck & 1; nch = 2; seqrow0 = (ck >> 1) * 256; }
        else { const int k2 = ck - 32; cis = k2 & 31; nch = 32; seqrow0 = NCTX + (k2 >> 5) * 4096; }
        const int t0 = cis * 128, T = nch * 128, row0 = seqrow0 + t0;
        __syncthreads();
        {
            const bf16_t* rp = REC + (size_t)seqrow0 * 1024 + cb * 256 + ch8 * 8;
            u32x4 wv[11];
            f32x4 cwv[4][2], cbv[2];
#pragma unroll
            for (int h2 = 0; h2 < 2; ++h2) { cbv[h2] = *(const f32x4*)(a.in[11] + cb * 256 + ch8 * 8 + 4 * h2);
#pragma unroll
                for (int k = 0; k < 4; ++k) cwv[k][h2] = *(const f32x4*)(a.in[10] + k * 1024 + cb * 256 + ch8 * 8 + 4 * h2); }
#pragma unroll
            for (int i = 0; i < 11; ++i) { const int tr = t0 + rgrp * 8 - 2 + i; const int trc = tr < 0 ? 0 : (tr >= T ? T - 1 : tr);
                const unsigned msk = (tr < 0 || tr >= T) ? 0u : 0xffffffffu;
                wv[i] = *(const u32x4*)(rp + (size_t)trc * 1024) & msk; }
            float prev[3][8] = {};
#pragma unroll
            for (int i = 0; i < 11; ++i) {
                const u32x4 w0 = wv[i]; float v[8];
                v[0] = bf_lo(w0.x); v[1] = bf_hi(w0.x); v[2] = bf_lo(w0.y); v[3] = bf_hi(w0.y); v[4] = bf_lo(w0.z); v[5] = bf_hi(w0.z); v[6] = bf_lo(w0.w); v[7] = bf_hi(w0.w);
                if (i >= 3) { float u[8];
#pragma unroll
                    for (int j = 0; j < 8; ++j) u[j] = cbv[j >> 2][j & 3] + cwv[0][j >> 2][j & 3] * prev[0][j] + cwv[1][j >> 2][j & 3] * prev[1][j] + cwv[2][j >> 2][j & 3] * prev[2][j] + cwv[3][j >> 2][j & 3] * v[j];
                    u32x4 w; w.x = cvt_pk_bf16(u[0], u[1]); w.y = cvt_pk_bf16(u[2], u[3]); w.z = cvt_pk_bf16(u[4], u[5]); w.w = cvt_pk_bf16(u[6], u[7]);
                    *(LAS u32x4*)(lds + (rgrp * 8 + i - 3) * UROW + ch8 * 16) = w; }
#pragma unroll
                for (int j = 0; j < 8; ++j) { prev[0][j] = prev[1][j]; prev[1][j] = prev[2][j]; prev[2][j] = v[j]; }
            }
        }
        bf16x8 Bf[2][8];
#pragma unroll
        for (int g = 0; g < 2; ++g)
#pragma unroll
            for (int ks = 0; ks < 8; ++ks) Bf[g][ks] = *(const bf16x8*)(WG + ((size_t)((0 * 2 + g) * 4 + cb) * 256 + ewave + cl) * 256 + ks * 32 + q * 8);
        __syncthreads();
#pragma unroll
        for (int dir = 0; dir < 2; ++dir) {
            if (dir == 1) {
#pragma unroll
                for (int g = 0; g < 2; ++g)
#pragma unroll
                    for (int ks = 0; ks < 8; ++ks) Bf[g][ks] = *(const bf16x8*)(WG + ((size_t)((1 * 2 + g) * 4 + cb) * 256 + ewave + cl) * 256 + ks * 32 + q * 8);
            }
            const int p = dir ? 3 - q : q;
            float Atot = 1.f, Btot = 0.f;
            unsigned* const dbase = (unsigned*)(a.ws + (dir ? WS_DBB : WS_DBF)) + (size_t)row0 * 1024;
            f32x4 nA = (f32x4){bA[dir], bA[dir], bA[dir], bA[dir]}, nX = (f32x4){bX[dir], bX[dir], bX[dir], bX[dir]};
            { const int m0 = dir ? 7 : 0;
#pragma unroll
              for (int ks = 0; ks < 8; ++ks) { const bf16x8 Af = *(const LAS bf16x8*)(lds + (16 * m0 + cl) * UROW + (ks * 32 + q * 8) * 2);
                  nA = __builtin_amdgcn_mfma_f32_16x16x32_bf16(Af, Bf[0][ks], nA, 0, 0, 0); nX = __builtin_amdgcn_mfma_f32_16x16x32_bf16(Af, Bf[1][ks], nX, 0, 0, 0); } }
#pragma unroll 1
            for (int mm = 0; mm < 8; ++mm) {
                const int m = dir ? 7 - mm : mm;
                const f32x4 accA = nA, accX = nX;
                { const int mn = (mm < 7) ? (dir ? 6 - mm : mm + 1) : m;
                  nA = (f32x4){bA[dir], bA[dir], bA[dir], bA[dir]}; nX = (f32x4){bX[dir], bX[dir], bX[dir], bX[dir]};
#pragma unroll
                  for (int ks = 0; ks < 8; ++ks) { const bf16x8 Af = *(const LAS bf16x8*)(lds + (16 * mn + cl) * UROW + (ks * 32 + q * 8) * 2);
                      nA = __builtin_amdgcn_mfma_f32_16x16x32_bf16(Af, Bf[0][ks], nA, 0, 0, 0); nX = __builtin_amdgcn_mfma_f32_16x16x32_bf16(Af, Bf[1][ks], nX, 0, 0, 0); } }
                unsigned* const drow = dbase + (size_t)(16 * m) * 1024;
                float aa[4], bb[4];
#pragma unroll
                for (int j = 0; j < 4; ++j) {
                    const float uval = __uint_as_float(((unsigned)*(const LAS unsigned short*)(lds + (16 * m + 4 * q + j) * UROW + (ewave + cl) * 2)) << 16);
                    const float t1 = 1.0f + __builtin_amdgcn_exp2f(accA[j]), t2 = 1.0f + __builtin_amdgcn_exp2f(accX[j]), inv = __builtin_amdgcn_rcpf(t1 * t2);
                    const float av = __builtin_amdgcn_exp2f(c8[dir] * (t2 * inv));
                    const float dv = 1.0f - av, bv = __builtin_amdgcn_sqrtf(fmaxf(dv * (1.0f + av), 0.f)) * ((t1 * inv) * uval);
                    __builtin_nontemporal_store(cvt_pk_bf16(dv, bv), drow + loff + j * 1024);
                    aa[j] = av; bb[j] = bv;
                }
                float Al = 1.f, Bl = 0.f;
#pragma unroll
                for (int jj = 0; jj < 4; ++jj) { const int j = dir ? 3 - jj : jj; Bl = aa[j] * Bl + bb[j]; Al *= aa[j]; }
                const float Ao = xchg16(Al, (q & 1) != 0), Bo = xchg16(Bl, (q & 1) != 0);
                const bool first = !(p & 1);
                const float A1 = first ? Al : Ao, B1 = first ? Bl : Bo, A2 = first ? Ao : Al, B2 = first ? Bo : Bl;
                const float Ap = A1 * A2, Bp = A2 * B1 + B2;
                const float Aq = xchg32(Ap, q >= 2), Bq = xchg32(Bp, q >= 2);
                const bool fp = !(p & 2);
                const float A01 = fp ? Ap : Aq, B01 = fp ? Bp : Bq, A23 = fp ? Aq : Ap, B23 = fp ? Bq : Bp;
                const float At = A01 * A23, Bt = A23 * B01 + B23;
                Btot = At * Btot + Bt; Atot *= At;
            }
            if (q == 0) { float* aA = AGG + (size_t)(dir * NCHUNK + ck) * 1024 + ch; aA[0] = Atot; aA[(size_t)2 * NCHUNK * 1024] = Btot; }
        }
    }
}

__device__ __forceinline__ void phase_apply(const Args& a) {
    const unsigned* DBF = (const unsigned*)(a.ws + WS_DBF); const unsigned* DBB = (const unsigned*)(a.ws + WS_DBB);
    const bf16_t* GACT = (const bf16_t*)(a.ws + WS_GACT); bf16_t* MIX = (bf16_t*)(a.ws + WS_REC); const float* CAR = (const float*)(a.ws + WS_CAR);
    for (int it = blockIdx.x; it < NCHUNK * 2; it += gridDim.x) {
        const int ck = it >> 1, ch = (it & 1) * 512 + threadIdx.x; const size_t o0 = (size_t)ck * 128 * 1024 + ch;
        float hf[128];
        {
            float h = CAR[(size_t)(0 * NCHUNK + ck) * 1024 + ch];
            unsigned w[16], wn[16];
#pragma unroll
            for (int j = 0; j < 16; ++j) { w[j] = __builtin_nontemporal_load(DBF + (o0 + (size_t)j * 1024)); wn[j] = 0u; }
#pragma unroll
            for (int blk = 0; blk < 8; ++blk) {
                if (blk < 7) {
#pragma unroll
                    for (int j = 0; j < 16; ++j) wn[j] = __builtin_nontemporal_load(DBF + (o0 + (size_t)((blk + 1) * 16 + j) * 1024));
                }
#pragma unroll
                for (int j = 0; j < 16; ++j) { h = __builtin_fmaf(-bf_lo(w[j]), h, h) + bf_hi(w[j]); hf[blk * 16 + j] = h; }
#pragma unroll
                for (int j = 0; j < 16; ++j) w[j] = wn[j];
            }
        }
        {
            float h = CAR[(size_t)(1 * NCHUNK + ck) * 1024 + ch];
            unsigned w[16], wn[16]; unsigned short g[16], gn[16];
#pragma unroll
            for (int j = 0; j < 16; ++j) { w[j] = __builtin_nontemporal_load(DBB + (o0 + (size_t)(7 * 16 + j) * 1024)); g[j] = __builtin_nontemporal_load(GACT + (o0 + (size_t)(7 * 16 + j) * 1024)); wn[j] = 0u; gn[j] = 0; }
#pragma unroll
            for (int blk = 7; blk >= 0; --blk) {
                if (blk > 0) {
#pragma unroll
                    for (int j = 0; j < 16; ++j) { wn[j] = __builtin_nontemporal_load(DBB + (o0 + (size_t)((blk - 1) * 16 + j) * 1024)); gn[j] = __builtin_nontemporal_load(GACT + (o0 + (size_t)((blk - 1) * 16 + j) * 1024)); }
                }
#pragma unroll
                for (int j = 15; j >= 0; --j) { h = __builtin_fmaf(-bf_lo(w[j]), h, h) + bf_hi(w[j]);
                    const float mv = (hf[blk * 16 + j] + h) * __uint_as_float(((unsigned)g[j]) << 16);
                    MIX[o0 + (size_t)(blk * 16 + j) * 1024] = (bf16_t)(cvt_pk_bf16(mv, 0.f) & 0xffffu); }
#pragma unroll
                for (int j = 0; j < 16; ++j) { w[j] = wn[j]; g[j] = gn[j]; }
            }
        }
    }
}

__device__ __forceinline__ void phase_carry(const Args& a) {
    const float* AGG = (const float*)(a.ws + WS_AGG); float* CAR = (float*)(a.ws + WS_CAR);
    for (int id = blockIdx.x * 512 + threadIdx.x; id < 24 * 2 * 1024; id += gridDim.x * 512) {
        const int ch = id & 1023, dir = (id >> 10) & 1, s = id >> 11;
        const bool lat = s >= 16; const int nch = lat ? 32 : 2, ck0 = lat ? 32 + (s - 16) * 32 : s * 2;
        float h = lat ? a.in[2][(size_t)((s - 16) * 2 + dir) * 1024 + ch] : 0.f;
        const float* aA = AGG + (size_t)(dir * NCHUNK + ck0) * 1024 + ch; const float* aB = aA + (size_t)2 * NCHUNK * 1024;
        float* cr = CAR + (size_t)(dir * NCHUNK + ck0) * 1024 + ch;
        float A[32], B[32];
#pragma unroll
        for (int k = 0; k < 32; ++k) { const int kk = k < nch ? k : nch - 1; A[k] = aA[(size_t)kk * 1024]; B[k] = aB[(size_t)kk * 1024]; }
        if (dir == 0) {
#pragma unroll
            for (int k = 0; k < 32; ++k) if (k < nch) { cr[(size_t)k * 1024] = h; h = A[k] * h + B[k]; }
        } else {
#pragma unroll
            for (int k = 31; k >= 0; --k) if (k < nch) { cr[(size_t)k * 1024] = h; h = A[k] * h + B[k]; }
        }
        if (!lat) a.out[(size_t)TROWS * 1024 + (size_t)(s * 2 + dir) * 1024 + ch] = h;
    }
}

template <int HALF>
__device__ __forceinline__ void pool_item(const float* X, const float* RSTD, bf16_t* P, int seqrow0, int T, int t0, int c, f32x2 Gm) {
    constexpr int NV = 16 + 2 * HALF;
    f32x2 v[NV];
#pragma unroll
    for (int i = 0; i < NV; ++i) { const int tt = t0 - HALF + i; const int tc = tt < 0 ? 0 : (tt >= T ? T - 1 : tt); const size_t r = (size_t)(seqrow0 + tc);
        const float vm = (tt < 0 || tt >= T) ? 0.f : RSTD[r];
        v[i] = *(const f32x2*)(X + r * D + c) * vm; }
    f32x2 S = (f32x2){0.f, 0.f};
#pragma unroll
    for (int i = 0; i < 2 * HALF; ++i) S += v[i];
#pragma unroll
    for (int j = 0; j < 16; ++j) { const int t = t0 + j; const int lo = (t - HALF) < 0 ? 0 : (t - HALF), hi = (t + HALF) > T ? T : (t + HALF);
        const f32x2 o = Gm * (S * (1.0f / (float)(hi - lo)) - v[j + HALF]);
        *(unsigned*)(P + (size_t)(seqrow0 + t) * D + c) = cvt_pk_bf16(o[0], o[1]);
        if (j < 15) S += v[j + 2 * HALF] - v[j]; }
}
__device__ __forceinline__ void phase_pool(const Args& a) {
    const int tid = threadIdx.x;
    const float* X = a.out; const float* RSTD = (const float*)(a.ws + WS_RSTD); bf16_t* P = (bf16_t*)(a.ws + WS_H);
    const float* MOD1 = (const float*)(a.ws + WS_MOD) + (size_t)9 * 6144;
    const int c = 2 * tid, g = tid >> 7;
    const f32x2 pg = *(const f32x2*)(a.in[24] + c);
    for (int it = blockIdx.x; it < TROWS / 16; it += gridDim.x) {
        const int row0 = it * 16;
        int seqrow0, T, cr;
        if (row0 < NCTX) { seqrow0 = row0 & ~255; T = 256; cr = 0; } else { const int lr = row0 - NCTX; seqrow0 = NCTX + (lr & ~4095); T = 4096; cr = 1 + (lr >> 12); }
        const f32x2 Gm = (*(const f32x2*)(MOD1 + (size_t)cr * 6144 + 1 * 1024 + c) + 1.0f) * pg;
        const int t0 = row0 - seqrow0;
        if (g == 0) pool_item<1>(X, RSTD, P, seqrow0, T, t0, c, Gm);
        else if (g == 1) pool_item<2>(X, RSTD, P, seqrow0, T, t0, c, Gm);
        else if (g == 2) pool_item<4>(X, RSTD, P, seqrow0, T, t0, c, Gm);
        else pool_item<8>(X, RSTD, P, seqrow0, T, t0, c, Gm);
    }
}

constexpr int XNROW = 260;
__device__ __forceinline__ void phase_poolmm(const Args& a, LAS unsigned char* lds) {
    const int tid = threadIdx.x, lane = tid & 63, wid = tid >> 6, q = lane >> 4, cl = lane & 15;
    const int g = blockIdx.x & 3, h = 1 << g;
    const float* X = a.out; const float* RSTD = (const float*)(a.ws + WS_RSTD); bf16_t* Y1 = (bf16_t*)(a.ws + WS_Y1);
    const float* MOD1 = (const float*)(a.ws + WS_MOD) + (size_t)9 * 6144;
    const bf16_t* WP = (const bf16_t*)(a.ws + WS_POOLW);
    LAS float* xnl = (LAS float*)lds;
    LAS unsigned char* pl = lds + 80 * XNROW * 4;
    bf16x8 Bf[2][8];
#pragma unroll
    for (int nt = 0; nt < 2; ++nt)
#pragma unroll
        for (int ks = 0; ks < 8; ++ks) Bf[nt][ks] = *(const bf16x8*)(WP + ((size_t)(g * 256 + wid * 32 + nt * 16 + cl)) * 256 + ks * 32 + q * 8);
    float pb[2], ps[2];
#pragma unroll
    for (int nt = 0; nt < 2; ++nt) { const int chn = g * 256 + wid * 32 + nt * 16 + cl; pb[nt] = a.in[27][chn]; ps[nt] = a.in[28][chn]; }
    const int c2 = tid & 127, tq = tid >> 7;
    const f32x2 pg = *(const f32x2*)(a.in[24] + g * 256 + 2 * c2);
    const int srow = tid >> 6, sc4 = tid & 63;
    const int nblk = gridDim.x >> 2;
    f32x4 xv[10]; float vmv[10];
#define PM_ISSUE(ttx) do { const int r0_ = (ttx) * 64; int s0_, s1_; if (r0_ < NCTX) { s0_ = r0_ & ~255; s1_ = s0_ + 256; } else { const int lr_ = r0_ - NCTX; s0_ = NCTX + (lr_ & ~4095); s1_ = s0_ + 4096; } \
        _Pragma("unroll") for (int i = 0; i < 10; ++i) { const int r = r0_ - 8 + srow + 8 * i; const int rc = r < s0_ ? s0_ : (r >= s1_ ? s1_ - 1 : r); \
            vmv[i] = (r < s0_ || r >= s1_) ? 0.f : RSTD[rc]; xv[i] = *(const f32x4*)(X + (size_t)rc * D + g * 256 + sc4 * 4); } } while (0)
    int tt = blockIdx.x >> 2;
    if (tt < TROWS / 64) PM_ISSUE(tt);
    for (; tt < TROWS / 64; tt += nblk) {
        const int r0 = tt * 64; int s0, s1, cr;
        if (r0 < NCTX) { s0 = r0 & ~255; s1 = s0 + 256; cr = 0; } else { const int lr = r0 - NCTX; s0 = NCTX + (lr & ~4095); s1 = s0 + 4096; cr = 1 + (lr >> 12); }
        __syncthreads();
#pragma unroll
        for (int i = 0; i < 10; ++i) *(LAS f32x4*)(xnl + (srow + 8 * i) * XNROW + sc4 * 4) = xv[i] * vmv[i];
        __syncthreads();
        {
            const f32x2 Gm = (*(const f32x2*)(MOD1 + (size_t)cr * 6144 + 1 * 1024 + g * 256 + 2 * c2) + 1.0f) * pg;
            const int tl0 = tq * 16;
            f32x2 S = (f32x2){0.f, 0.f};
            for (int d = -h; d < h; ++d) S += *(const LAS f32x2*)(xnl + (tl0 + 8 + d) * XNROW + 2 * c2);
#pragma unroll 4
            for (int j = 0; j < 16; ++j) { const int tl = tl0 + j, t = r0 + tl; const int lo = (t - h) < s0 ? s0 : (t - h), hi = (t + h) > s1 ? s1 : (t + h);
                const f32x2 xc = *(const LAS f32x2*)(xnl + (tl + 8) * XNROW + 2 * c2);
                const f32x2 o = Gm * (S * (1.0f / (float)(hi - lo)) - xc);
                *(LAS unsigned*)(pl + tl * UROW + c2 * 4) = cvt_pk_bf16(o[0], o[1]);
                S += *(const LAS f32x2*)(xnl + (tl + 8 + h) * XNROW + 2 * c2) - *(const LAS f32x2*)(xnl + (tl + 8 - h) * XNROW + 2 * c2); }
        }
        { const int ttn = (tt + nblk < TROWS / 64) ? tt + nblk : tt; PM_ISSUE(ttn); }
        __syncthreads();
#pragma unroll 1
        for (int m = 0; m < 4; ++m) {
            f32x4 acc[2] = {(f32x4){0.f, 0.f, 0.f, 0.f}, (f32x4){0.f, 0.f, 0.f, 0.f}};
#pragma unroll
            for (int ks = 0; ks < 8; ++ks) { const bf16x8 Af = *(const LAS bf16x8*)(pl + (16 * m + cl) * UROW + (ks * 32 + q * 8) * 2);
                acc[0] = __builtin_amdgcn_mfma_f32_16x16x32_bf16(Af, Bf[0][ks], acc[0], 0, 0, 0); acc[1] = __builtin_amdgcn_mfma_f32_16x16x32_bf16(Af, Bf[1][ks], acc[1], 0, 0, 0); }
            bf16_t* const yrow = Y1 + (size_t)(r0 + 16 * m) * 1024;
#pragma unroll
            for (int nt = 0; nt < 2; ++nt)
#pragma unroll
                for (int j = 0; j < 4; ++j) yrow[(4 * q + j) * 1024 + g * 256 + wid * 32 + nt * 16 + cl] = (bf16_t)(cvt_pk_bf16((acc[nt][j] + pb[nt]) * ps[nt], 0.f) & 0xffffu);
        }
    }
#undef PM_ISSUE
}

__global__ void __launch_bounds__(512, 2) mk_fwd(Args a) {
    extern __shared__ __attribute__((aligned(16))) unsigned char lds_raw[];
    LAS unsigned char* lds = (LAS unsigned char*)lds_raw;
    unsigned char* ws = a.ws;
    const float* MOD0 = (const float*)(ws + WS_MOD); const float* MOD1 = MOD0 + (size_t)9 * 6144;
    bf16_t* Hb = (bf16_t*)(ws + WS_H); bf16_t* Yb = (bf16_t*)(ws + WS_Y); bf16_t* Bb = (bf16_t*)(ws + WS_B);
    const int lo = a.ph_lo, hi = a.ph_hi;
    volatile LAS unsigned* bst = (volatile LAS unsigned*)(lds + LDS_BYTES - 16);
    if (threadIdx.x < 4) bst[threadIdx.x] = 0u;
    __syncthreads();
    XcdBarrier bar; bar.bar = (unsigned*)(ws + WS_BAR); bar.x = 0; bar.st = bst;
    if (hi - lo > 1) bar = xcd_barrier_post((unsigned*)(ws + WS_BAR), bst);
    if (hi > NPH) cg::this_grid().sync();
#define GRID_BAR() xcd_barrier(bar)
#define IN(k) ((PH_MASK & (1 << (k))) && lo <= (k) && (k) < hi)
#define SEAM(k) do { if (lo <= (k) && (k) + 1 < hi) GRID_BAR(); } while (0)
#define REPS(k) (((REP_MASK) >> (k)) & 1 ? 2 : 1)
#define RUN_GEMM(k, tl) do { for (int rep_ = 0; rep_ < REPS(k); ++rep_) { pg8::StaticOrder S; S.init(g.M, g.N, g.K, (int)gridDim.x, (int)blockIdx.x, tl); pg8::gemm_phase(lds, g, S, E); if (rep_ + 1 < REPS(k)) GRID_BAR(); } } while (0)
#define RUN(k, call) do { if (IN(k)) for (int rep_ = 0; rep_ < REPS(k); ++rep_) { call; if (rep_ + 1 < REPS(k)) GRID_BAR(); } SEAM(k); } while (0)
    float* const PARTp = (float*)(ws + WS_H);
    RUN(0, phase_prologue(a, lds));
    RUN(1, phase_rows<0>(a, nullptr, 0, nullptr, MOD0, 0, 1, a.in[7]));
    if (IN(2)) { pg8::Gemm g{Hb, (const bf16_t*)(ws + WS_WIN0), TROWS, 2048, 1024, 1024, 0}; pg8::Epi E{0, (bf16_t*)(ws + WS_GACT), (bf16_t*)(ws + WS_REC), nullptr, nullptr, nullptr, 16}; RUN_GEMM(2, 0); }
    SEAM(2);
    RUN(3, phase_scan(a, lds));
    RUN(4, phase_carry(a));
    RUN(5, phase_apply(a));
    if (IN(6)) { pg8::Gemm g{(const bf16_t*)(ws + WS_REC), (const bf16_t*)(ws + WS_WOUT0), TROWS, 1024, 1024, 1024, 0}; pg8::Epi E{1, (bf16_t*)(ws + WS_Y1), nullptr, nullptr, nullptr, nullptr, 16}; RUN_GEMM(6, 0); }
    SEAM(6);
    if (IN(7)) phase_rows2<true, false, 0>(a, MOD0, a.in[8], nullptr, a.in[18]);
    SEAM(7);
    if (IN(8)) { pg8::Gemm g{Hb, (const bf16_t*)(ws + WS_FIN0), TROWS, 2 * DFF, 1024, 1024, 0}; pg8::Epi E{2, Bb, nullptr, nullptr, nullptr, nullptr, 16}; RUN_GEMM(8, 0); }
    SEAM(8);
    if (IN(9)) { pg8::Gemm g{Bb, (const bf16_t*)(ws + WS_FOUT0), TROWS, 1024, DFF, DFF, 0}; pg8::Epi E{1, Yb, nullptr, nullptr, nullptr, PARTp, 44}; RUN_GEMM(9, 3); }
    SEAM(9);
    if (IN(11)) phase_rows2<true, true, 1>(a, MOD0, a.in[8], a.in[19], nullptr);
    SEAM(11);
    RUN(12, phase_poolmm(a, lds));
    if (IN(14)) phase_rows2<false, false, 0>(a, MOD1, a.in[25], nullptr, a.in[29]);
    SEAM(14);
    if (IN(15)) { pg8::Gemm g{Hb, (const bf16_t*)(ws + WS_FIN1), TROWS, 2 * DFF, 1024, 1024, 0}; pg8::Epi E{2, Bb, nullptr, nullptr, nullptr, nullptr, 16}; RUN_GEMM(15, 0); }
    SEAM(15);
    if (IN(16)) { pg8::Gemm g{Bb, (const bf16_t*)(ws + WS_FOUT1), TROWS, 1024, DFF, DFF, 0}; pg8::Epi E{1, Yb, nullptr, nullptr, nullptr, PARTp, 44}; RUN_GEMM(16, 3); }
    SEAM(16);
    if (IN(18)) phase_rows2<false, true, 2>(a, MOD1, a.in[25], a.in[30], nullptr);
#undef RUN
#undef GRID_BAR
#undef IN
#undef SEAM
#undef RUN_GEMM
#undef REPS
}

extern "C" void kernel_launch(void* const* d_in, const int* in_sizes, int n_in, void* d_out, int out_size, void* d_ws, size_t ws_size, hipStream_t stream) {
    static int grid = 0;
    if (grid == 0) {
        if (n_in != 33 || ws_size < WS_END) { fprintf(stderr, "kernel_launch: need 33 inputs and %zu bytes of workspace; got %d, %zu\n", (size_t)WS_END, n_in, ws_size); grid = -1; return; }
        int dev = 0, cus = 0, per_cu = 0;
        hipGetDevice(&dev); hipDeviceGetAttribute(&cus, hipDeviceAttributeMultiprocessorCount, dev);
        if (hipFuncSetAttribute((const void*)mk_fwd, hipFuncAttributeMaxDynamicSharedMemorySize, LDS_BYTES) != hipSuccess) { fprintf(stderr, "kernel_launch: hipFuncSetAttribute failed\n"); grid = -1; return; }
        if (hipOccupancyMaxActiveBlocksPerMultiprocessor(&per_cu, (const void*)mk_fwd, 512, LDS_BYTES) != hipSuccess || per_cu < 1) { fprintf(stderr, "kernel_launch: occupancy query says %d\n", per_cu); per_cu = 1; }
        (void)hipGetLastError();
        grid = cus;
    }
    if (grid < 0) return;
    if (hipMemsetAsync((char*)d_ws + WS_BAR, 0, WS_BAR_BYTES, stream) != hipSuccess) { fprintf(stderr, "kernel_launch: memset of the barrier words failed\n"); return; }
    Args a{};
    for (int i = 0; i < 33; ++i) a.in[i] = (const float*)d_in[i];
    a.out = (float*)d_out; a.ws = (unsigned char*)d_ws;
#if MK_PER_PHASE
    for (int ph = 0; ph < NPH; ++ph) { a.ph_lo = ph; a.ph_hi = ph + 1; hipLaunchKernelGGL(mk_fwd, dim3(grid), dim3(512), LDS_BYTES, stream, a); }
#else
    a.ph_lo = 0; a.ph_hi = NPH;
    void* args[] = {&a};
    hipError_t e = hipLaunchCooperativeKernel((const void*)mk_fwd, dim3(grid), dim3(512), args, LDS_BYTES, stream);
    if (e != hipSuccess) fprintf(stderr, "cooperative launch failed: %s (grid %d)\n", hipGetErrorString(e), grid);
#endif
}
```
